# Optimizing an MI355X kernel written in HIP

```python
import math
import jax
import jax.numpy as jnp
from jax import lax
import numpy as np


D_MODEL = 1024
BATCH = 8
SEQ = 2048
DEPTH = 4

PLE_DIM = 256
N_EVEN = (DEPTH + 1) // 2
N_ODD = DEPTH // 2
EPS = 1e-6
NEG = -1e30

S5_WIDTH = D_MODEL // 2
S5_GROUP = 16
S5_GROUPS = S5_WIDTH // S5_GROUP
S5_STATE = 64
CONV_WIDTH = D_MODEL // 2
CONV_K = 31
NSA_HEADS = D_MODEL // 128
NSA_KV_HEADS = 2
NSA_GQA = NSA_HEADS // NSA_KV_HEADS
NSA_HEAD_DIM = 64
NSA_WIDTH = NSA_HEADS * NSA_HEAD_DIM
CMP_LEN = 32
CMP_STRIDE = 16
CMP_HIDDEN = 256
SEL_LEN = 64
SEL_TOPN = 8
WINDOW = 512
Q_BLOCK = 128
MLA_HEADS = D_MODEL // 128
MLA_NOPE = 64
MLA_ROPE = 32
MLA_V = 64
MLA_Q_RANK = 256
MLA_KV_RANK = 128
MLA_WIDTH = MLA_HEADS * MLA_V
ROPE_BASE = 10000.0

EVEN_SPLITS = (S5_WIDTH, S5_WIDTH, 2 * CONV_WIDTH, CONV_WIDTH)
ODD_SPLITS = (NSA_WIDTH, 6 * NSA_KV_HEADS * NSA_HEAD_DIM, 3 * NSA_HEADS, NSA_WIDTH,
              MLA_Q_RANK, MLA_KV_RANK, MLA_ROPE, MLA_WIDTH)
EVEN_IN = sum(EVEN_SPLITS)
ODD_IN = sum(ODD_SPLITS)
EVEN_MIX = S5_WIDTH + CONV_WIDTH
ODD_MIX = NSA_WIDTH + MLA_WIDTH

kernel_name = 'hybrid_s5conv_nsamla_trunk'


def rms_norm(x, g):
    xf = x.astype(jnp.float32)
    y = xf * lax.rsqrt(jnp.mean(xf * xf, axis=-1, keepdims=True) + EPS)
    return (y * g.astype(jnp.float32)).astype(x.dtype)


def layer_norm(x, g, b):
    xf = x.astype(jnp.float32)
    mu = jnp.mean(xf, axis=-1, keepdims=True)
    var = jnp.mean(jnp.square(xf - mu), axis=-1, keepdims=True)
    return ((xf - mu) * lax.rsqrt(var + EPS) * g + b).astype(x.dtype)


def split_cols(h, sizes):
    return jnp.split(h, np.cumsum(sizes)[:-1].tolist(), axis=-1)


def masked_softmax(s, mask):
    s = jnp.where(mask, s.astype(jnp.float32), NEG)
    m = jnp.max(s, axis=-1, keepdims=True)
    e = jnp.exp(s - m) * mask
    return e / jnp.maximum(jnp.sum(e, axis=-1, keepdims=True), 1e-30)


def alibi_slopes(n):
    return np.array([2.0 ** (-8.0 * (i + 1) / n) for i in range(n)], np.float32)


def rope(x, positions):
    half = MLA_ROPE // 2
    freqs = ROPE_BASE ** (-jnp.arange(half, dtype=jnp.float32) / half)
    ang = positions.astype(jnp.float32)[..., None] * freqs
    cos = jnp.cos(ang)[:, :, None, :]
    sin = jnp.sin(ang)[:, :, None, :]
    x1, x2 = x[..., :half], x[..., half:]
    return jnp.concatenate([x1 * cos - x2 * sin, x1 * sin + x2 * cos], axis=-1).astype(x.dtype)


def s5_mixer(u, lam_re, lam_im, b_re, b_im, c_re, c_im, d_skip, log_step, w_glu, b_glu):
    f32 = jnp.float32
    bsz, s_len, _ = u.shape
    step = jnp.exp(log_step.astype(f32))[:, None]
    lr, li = lam_re.astype(f32), lam_im.astype(f32)
    mag = jnp.exp(lr * step)
    ab_re, ab_im = mag * jnp.cos(li * step), mag * jnp.sin(li * step)
    den = lr * lr + li * li
    nr, ni = ab_re - 1.0, ab_im
    f_re, f_im = (nr * lr + ni * li) / den, (ni * lr - nr * li) / den
    br, bi = b_re.astype(f32), b_im.astype(f32)
    bb_re = f_re[..., None] * br - f_im[..., None] * bi
    bb_im = f_re[..., None] * bi + f_im[..., None] * br
    ut = jnp.swapaxes(u.astype(f32).reshape(bsz, s_len, S5_GROUPS, S5_GROUP), 0, 1)
    bu_re = jnp.einsum('sbgc,gnc->sbgn', ut, bb_re)
    bu_im = jnp.einsum('sbgc,gnc->sbgn', ut, bb_im)
    a_re = jnp.broadcast_to(ab_re[None, None], (s_len, 1, S5_GROUPS, S5_STATE))
    a_im = jnp.broadcast_to(ab_im[None, None], (s_len, 1, S5_GROUPS, S5_STATE))

    def combine(e1, e2):
        a1r, a1i, b1r, b1i = e1
        a2r, a2i, b2r, b2i = e2
        return (a2r * a1r - a2i * a1i, a2r * a1i + a2i * a1r,
                a2r * b1r - a2i * b1i + b2r, a2r * b1i + a2i * b1r + b2i)

    _, _, x_re, x_im = lax.associative_scan(combine, (a_re, a_im, bu_re, bu_im), axis=0)
    y = (jnp.einsum('sbgn,gcn->sbgc', x_re, c_re.astype(f32))
         - jnp.einsum('sbgn,gcn->sbgc', x_im, c_im.astype(f32)))
    y = jnp.swapaxes(y, 0, 1).reshape(bsz, s_len, S5_WIDTH) + d_skip * u
    y = jax.nn.gelu(y)
    return (y * jax.nn.sigmoid(y @ w_glu + b_glu)).astype(u.dtype)


def conv_mixer(v, w_dw, b_dw, ln_g, ln_b, w_pw):
    a, g = jnp.split(v, 2, axis=-1)
    h = a * jax.nn.sigmoid(g)
    h = lax.conv_general_dilated(h, w_dw[:, None, :].astype(h.dtype), window_strides=(1,),
                                 padding=[(CONV_K - 1, 0)],
                                 dimension_numbers=('NWC', 'WIO', 'NWC'),
                                 feature_group_count=CONV_WIDTH) + b_dw
    h = jax.nn.silu(layer_norm(h, ln_g, ln_b))
    return h @ w_pw


def even_mixer(h, w_in, lam_re, lam_im, b_re, b_im, c_re, c_im, d_skip, log_step, w_glu, b_glu,
               w_dw, b_dw, ln_g, ln_b, w_pw, w_out):
    u_a, g_a, v_b, g_b = split_cols(h @ w_in, EVEN_SPLITS)
    y_a = s5_mixer(u_a, lam_re, lam_im, b_re, b_im, c_re, c_im, d_skip, log_step, w_glu, b_glu) * jax.nn.silu(g_a)
    y_b = conv_mixer(v_b, w_dw, b_dw, ln_g, ln_b, w_pw) * jax.nn.silu(g_b)
    return jnp.concatenate([y_a, y_b], axis=-1) @ w_out


def compress_blocks(k, cmp_idx, pos, w1, w2):
    bsz, nc = k.shape[0], cmp_idx.shape[0]
    blk = k[:, cmp_idx] + pos[:, None, :]
    blk = jnp.moveaxis(blk, 3, 2).reshape(bsz, nc, NSA_KV_HEADS, CMP_LEN * NSA_HEAD_DIM)
    return jax.nn.gelu(blk @ w1) @ w2


def nsa_mixer(q, kv, gate_logits, cmp_pos_k, cmp_pos_v, ck_w1, ck_w2, cv_w1, cv_w2):
    f32 = jnp.float32
    bsz, s_len = q.shape[:2]
    hkv, grp, dh = NSA_KV_HEADS, NSA_GQA, NSA_HEAD_DIM
    k_cmp, v_cmp, k_sel, v_sel, k_win, v_win = [kv[:, :, i] for i in range(6)]
    qg = q.reshape(bsz, s_len, hkv, grp, dh)
    scale = dh ** -0.5
    slopes = jnp.asarray(alibi_slopes(NSA_HEADS)).reshape(hkv, grp)
    t = np.arange(s_len)

    nc = (s_len - CMP_LEN) // CMP_STRIDE + 1
    cmp_idx = np.arange(nc)[:, None] * CMP_STRIDE + np.arange(CMP_LEN)[None]
    kc = compress_blocks(k_cmp, cmp_idx, cmp_pos_k, ck_w1, ck_w2)
    vc = compress_blocks(v_cmp, cmp_idx, cmp_pos_v, cv_w1, cv_w2)
    dist_c = (t[:, None] - cmp_idx[:, -1][None]).astype(np.float32)
    s_c = jnp.einsum('bsygd,bcyd->bygsc', qg, kc).astype(f32) * scale - slopes[:, :, None, None] * dist_c
    p_c = masked_softmax(s_c, jnp.asarray(dist_c >= 0))
    o_cmp = jnp.einsum('bygsc,bcyd->bsygd', p_c, vc)

    ns = s_len // SEL_LEN
    n_top = min(SEL_TOPN, ns)
    sb = np.arange(ns)
    cs = np.arange(nc)[:, None] * CMP_STRIDE
    overlap = ((cs < (sb[None] + 1) * SEL_LEN) & (cs + CMP_LEN > sb[None] * SEL_LEN)).astype(np.float32)
    p_slc = jnp.einsum('bygsc,cj->bysj', p_c, jnp.asarray(overlap))
    cur = t[:, None] // SEL_LEN
    forced = (sb[None] == 0) | (sb[None] == cur) | (sb[None] == cur - 1)
    causal_blk = sb[None] * SEL_LEN <= t[:, None]
    sel_score = jnp.where(forced, p_slc + 1e4, jnp.where(causal_blk, p_slc, -1e4))
    _, sel_idx = lax.top_k(sel_score, n_top)

    k_blk = jnp.moveaxis(k_sel.reshape(bsz, ns, SEL_LEN, hkv, dh), 3, 1)
    v_blk = jnp.moveaxis(v_sel.reshape(bsz, ns, SEL_LEN, hkv, dh), 3, 1)
    k_pad = jnp.pad(k_win, ((0, 0), (WINDOW, 0), (0, 0), (0, 0)))
    v_pad = jnp.pad(v_win, ((0, 0), (WINDOW, 0), (0, 0), (0, 0)))
    bi = jnp.arange(bsz)[:, None, None, None]
    hi = jnp.arange(hkv)[None, :, None, None]
    span = WINDOW + Q_BLOCK
    n_sel_keys = n_top * SEL_LEN

    def one_block(i):
        t0 = i * Q_BLOCK
        tq = t0 + jnp.arange(Q_BLOCK)
        qb = lax.dynamic_slice_in_dim(qg, t0, Q_BLOCK, axis=1)
        ib = lax.dynamic_slice_in_dim(sel_idx, t0, Q_BLOCK, axis=2)
        ks = k_blk[bi, hi, ib].reshape(bsz, hkv, Q_BLOCK, n_sel_keys, dh)
        vs = v_blk[bi, hi, ib].reshape(bsz, hkv, Q_BLOCK, n_sel_keys, dh)
        kpos = (ib[..., None] * SEL_LEN + jnp.arange(SEL_LEN)).reshape(bsz, hkv, Q_BLOCK, n_sel_keys)
        dist = (tq[None, None, :, None] - kpos).astype(f32)[:, :, None]
        s_s = jnp.einsum('bqygd,byqkd->bygqk', qb, ks).astype(f32) * scale - slopes[None, :, :, None, None] * dist
        p_s = masked_softmax(s_s, dist >= 0)
        o_sel = jnp.einsum('bygqk,byqkd->bqygd', p_s, vs)
        kw = lax.dynamic_slice_in_dim(k_pad, t0, span, axis=1)
        vw = lax.dynamic_slice_in_dim(v_pad, t0, span, axis=1)
        kpos_w = t0 - WINDOW + jnp.arange(span)
        dist_w = (tq[:, None] - kpos_w[None]).astype(f32)
        mask_w = (dist_w >= 0) & (dist_w < WINDOW) & (kpos_w[None] >= 0)
        s_w = jnp.einsum('bqygd,bkyd->bygqk', qb, kw).astype(f32) * scale - slopes[:, :, None, None] * dist_w
        p_w = masked_softmax(s_w, mask_w)
        o_win = jnp.einsum('bygqk,bkyd->bqygd', p_w, vw)
        return o_sel, o_win

    o_sel, o_win = lax.map(one_block, jnp.arange(s_len // Q_BLOCK))
    o_sel = jnp.moveaxis(o_sel, 0, 1).reshape(bsz, s_len, hkv, grp, dh)
    o_win = jnp.moveaxis(o_win, 0, 1).reshape(bsz, s_len, hkv, grp, dh)
    g = jax.nn.sigmoid(gate_logits.astype(f32)).reshape(bsz, s_len, 3, hkv, grp)[..., None]
    o = g[:, :, 0] * o_cmp + g[:, :, 1] * o_sel + g[:, :, 2] * o_win
    return o.reshape(bsz, s_len, NSA_WIDTH)


def mla_mixer(c_q, c_kv, k_rope, positions, q_norm, kv_norm, w_uq, w_ukv):
    f32 = jnp.float32
    bsz, s_len = c_q.shape[:2]
    q = (rms_norm(c_q, q_norm) @ w_uq).reshape(bsz, s_len, MLA_HEADS, MLA_NOPE + MLA_ROPE)
    kv = (rms_norm(c_kv, kv_norm) @ w_ukv).reshape(bsz, s_len, MLA_HEADS, MLA_NOPE + MLA_V)
    q = jnp.concatenate([q[..., :MLA_NOPE], rope(q[..., MLA_NOPE:], positions)], axis=-1)
    k_r = jnp.broadcast_to(rope(k_rope[:, :, None, :], positions), (bsz, s_len, MLA_HEADS, MLA_ROPE))
    k = jnp.concatenate([kv[..., :MLA_NOPE], k_r], axis=-1)
    v = kv[..., MLA_NOPE:]
    scale = (MLA_NOPE + MLA_ROPE) ** -0.5
    kpos = jnp.arange(s_len)

    def one_block(i):
        t0 = i * Q_BLOCK
        qb = lax.dynamic_slice_in_dim(q, t0, Q_BLOCK, axis=1)
        s = jnp.einsum('bqhd,bkhd->bhqk', qb, k).astype(f32) * scale
        mask = kpos[None] <= (t0 + jnp.arange(Q_BLOCK))[:, None]
        return jnp.einsum('bhqk,bkhd->bqhd', masked_softmax(s, mask), v)

    o = lax.map(one_block, jnp.arange(s_len // Q_BLOCK))
    return jnp.moveaxis(o, 0, 1).reshape(bsz, s_len, MLA_WIDTH)


def odd_mixer(h, positions, w_in, cmp_pos_k, cmp_pos_v, ck_w1, ck_w2, cv_w1, cv_w2,
              q_norm, kv_norm, w_uq, w_ukv, w_out):
    bsz, s_len = h.shape[:2]
    q_n, kv_n, gl_n, g_n, c_q, c_kv, k_r, g_m = split_cols(h @ w_in, ODD_SPLITS)
    q_n = q_n.reshape(bsz, s_len, NSA_HEADS, NSA_HEAD_DIM)
    kv_n = kv_n.reshape(bsz, s_len, 6, NSA_KV_HEADS, NSA_HEAD_DIM)
    y_c = nsa_mixer(q_n, kv_n, gl_n, cmp_pos_k, cmp_pos_v, ck_w1, ck_w2, cv_w1, cv_w2) * jax.nn.silu(g_n)
    y_d = mla_mixer(c_q, c_kv, k_r, positions, q_norm, kv_norm, w_uq, w_ukv) * jax.nn.silu(g_m)
    return jnp.concatenate([y_c, y_d], axis=-1) @ w_out


def setup_inputs(seed: int = 0) -> dict:
    key = jax.random.key(seed)
    ks = iter(jax.random.split(key, 40))

    def nrm(shape, scale):
        return jax.random.normal(next(ks), shape, jnp.float32) * scale

    def gain(shape):
        return 1.0 + nrm(shape, 0.02)

    ne, no = N_EVEN, N_ODD
    g, n, c = S5_GROUPS, S5_STATE, S5_GROUP
    return {
        'x': nrm((BATCH, SEQ, D_MODEL), 1.0),
        'p': nrm((DEPTH, BATCH, SEQ, PLE_DIM), 1.0),
        'positions': jnp.broadcast_to(jnp.arange(SEQ, dtype=jnp.int32), (BATCH, SEQ)),
        'pre_norm': gain((DEPTH, D_MODEL)),
        'post_norm': gain((DEPTH, D_MODEL)),
        'ple_gate': nrm((DEPTH, D_MODEL, D_MODEL), D_MODEL ** -0.5),
        'ple_proj': nrm((DEPTH, PLE_DIM, D_MODEL), PLE_DIM ** -0.5),
        'ev_w_in': nrm((ne, D_MODEL, EVEN_IN), D_MODEL ** -0.5),
        's5_lam_re': -0.5 * jnp.exp(nrm((ne, g, n), 0.01)),
        's5_lam_im': jnp.pi * jnp.arange(n, dtype=jnp.float32) + nrm((ne, g, n), 0.01),
        's5_b_re': nrm((ne, g, n, c), (2 * c) ** -0.5),
        's5_b_im': nrm((ne, g, n, c), (2 * c) ** -0.5),
        's5_c_re': nrm((ne, g, c, n), (2 * n) ** -0.5),
        's5_c_im': nrm((ne, g, c, n), (2 * n) ** -0.5),
        's5_d': nrm((ne, S5_WIDTH), 0.5),
        's5_log_step': jax.random.uniform(next(ks), (ne, g), jnp.float32, math.log(1e-3), math.log(1e-1)),
        's5_w_glu': nrm((ne, S5_WIDTH, S5_WIDTH), S5_WIDTH ** -0.5),
        's5_b_glu': nrm((ne, S5_WIDTH), 0.01),
        'cv_w_dw': nrm((ne, CONV_K, CONV_WIDTH), CONV_K ** -0.5),
        'cv_b_dw': nrm((ne, CONV_WIDTH), 0.01),
        'cv_ln_g': gain((ne, CONV_WIDTH)),
        'cv_ln_b': nrm((ne, CONV_WIDTH), 0.01),
        'cv_w_pw': nrm((ne, CONV_WIDTH, CONV_WIDTH), CONV_WIDTH ** -0.5),
        'ev_w_out': nrm((ne, EVEN_MIX, D_MODEL), EVEN_MIX ** -0.5),
        'od_w_in': nrm((no, D_MODEL, ODD_IN), D_MODEL ** -0.5),
        'nsa_pos_k': nrm((no, CMP_LEN, NSA_HEAD_DIM), 0.1),
        'nsa_pos_v': nrm((no, CMP_LEN, NSA_HEAD_DIM), 0.1),
        'nsa_ck_w1': nrm((no, CMP_LEN * NSA_HEAD_DIM, CMP_HIDDEN), (CMP_LEN * NSA_HEAD_DIM) ** -0.5),
        'nsa_ck_w2': nrm((no, CMP_HIDDEN, NSA_HEAD_DIM), CMP_HIDDEN ** -0.5),
        'nsa_cv_w1': nrm((no, CMP_LEN * NSA_HEAD_DIM, CMP_HIDDEN), (CMP_LEN * NSA_HEAD_DIM) ** -0.5),
        'nsa_cv_w2': nrm((no, CMP_HIDDEN, NSA_HEAD_DIM), CMP_HIDDEN ** -0.5),
        'mla_q_norm': gain((no, MLA_Q_RANK)),
        'mla_kv_norm': gain((no, MLA_KV_RANK)),
        'mla_w_uq': nrm((no, MLA_Q_RANK, MLA_HEADS * (MLA_NOPE + MLA_ROPE)), MLA_Q_RANK ** -0.5),
        'mla_w_ukv': nrm((no, MLA_KV_RANK, MLA_HEADS * (MLA_NOPE + MLA_V)), MLA_KV_RANK ** -0.5),
        'od_w_out': nrm((no, ODD_MIX, D_MODEL), ODD_MIX ** -0.5),
    }


def reference(x, p, positions, pre_norm, post_norm, ple_gate, ple_proj,
              ev_w_in, s5_lam_re, s5_lam_im, s5_b_re, s5_b_im, s5_c_re, s5_c_im, s5_d, s5_log_step,
              s5_w_glu, s5_b_glu, cv_w_dw, cv_b_dw, cv_ln_g, cv_ln_b, cv_w_pw, ev_w_out,
              od_w_in, nsa_pos_k, nsa_pos_v, nsa_ck_w1, nsa_ck_w2, nsa_cv_w1, nsa_cv_w2,
              mla_q_norm, mla_kv_norm, mla_w_uq, mla_w_ukv, od_w_out):
    h = x
    for i in range(DEPTH):
        hn = rms_norm(h, pre_norm[i])
        j = i // 2
        if i % 2 == 0:
            y = even_mixer(hn, ev_w_in[j], s5_lam_re[j], s5_lam_im[j], s5_b_re[j], s5_b_im[j],
                           s5_c_re[j], s5_c_im[j], s5_d[j], s5_log_step[j], s5_w_glu[j], s5_b_glu[j],
                           cv_w_dw[j], cv_b_dw[j], cv_ln_g[j], cv_ln_b[j], cv_w_pw[j], ev_w_out[j])
        else:
            y = odd_mixer(hn, positions, od_w_in[j], nsa_pos_k[j], nsa_pos_v[j], nsa_ck_w1[j], nsa_ck_w2[j],
                          nsa_cv_w1[j], nsa_cv_w2[j], mla_q_norm[j], mla_kv_norm[j], mla_w_uq[j],
                          mla_w_ukv[j], od_w_out[j])
        h = h + rms_norm(y, post_norm[i])
        h = h + jax.nn.sigmoid(h @ ple_gate[i]) * (p[i] @ ple_proj[i])
    return h
```

```cpp
#include <hip/hip_runtime.h>
#include <hip/hip_cooperative_groups.h>
#include <stdint.h>
#include <cstdio>
namespace cg = cooperative_groups;

typedef unsigned short bf16_t;
typedef short bf16x8 __attribute__((ext_vector_type(8)));
typedef short s16x4 __attribute__((ext_vector_type(4)));
typedef float f32x4 __attribute__((ext_vector_type(4)));
typedef unsigned int u32x4 __attribute__((ext_vector_type(4)));

#define DEV __device__ __forceinline__
#define LAS3 __attribute__((address_space(3)))

constexpr int T_TOK = 16384, SEQL = 2048, DM = 1024, LDP = 2816;
constexpr int NTHREADS = 256;
constexpr int LDS_BYTES = 80896;
constexpr float LOG2E = 1.4426950408889634f;

constexpr size_t MBY = 1u << 20;
constexpr size_t OFF_W = 0;
constexpr size_t OFF_PROJ = 48 * MBY;
constexpr size_t OFF_MIX = OFF_PROJ + 88 * MBY;
constexpr size_t OFF_HB2 = OFF_MIX + 32 * MBY;
constexpr size_t OFF_PB = OFF_HB2 + 32 * MBY;
constexpr size_t OFF_MK = OFF_PB + 8 * MBY;
constexpr size_t OFF_MV = OFF_MK + 24 * MBY;
constexpr size_t OFF_SMALL = OFF_MV + 16 * MBY;
constexpr size_t OFF_GL = OFF_SMALL;
constexpr size_t OFF_HID = OFF_GL + 2 * MBY;
constexpr size_t OFF_KC = OFF_HID + 2 * MBY;
constexpr size_t OFF_VC = OFF_KC + 262144;
constexpr size_t OFF_RSPRE = OFF_VC + 262144;
constexpr size_t OFF_RSPOST = OFF_RSPRE + 65536;
constexpr size_t OFF_S5A = OFF_RSPOST + 65536;
constexpr size_t OFF_BBR = OFF_S5A + 65536;
constexpr size_t OFF_BBI = OFF_BBR + 262144;
constexpr size_t OFF_CM = OFF_BBI + 262144;
constexpr size_t OFF_POSB = OFF_CM + 262144;
constexpr size_t OFF_ROPE = OFF_POSB + 4096;
constexpr size_t OFF_BAR = OFF_ROPE + 2 * MBY;
constexpr size_t WS_NEED = OFF_BAR + 16384;

constexpr size_t WE_GATE = 0;
constexpr size_t WE_PPROJ = WE_GATE + 4 * 1048576;
constexpr size_t WE_EVIN = WE_PPROJ + 4 * 262144;
constexpr size_t WE_GLU = WE_EVIN + 2 * 2560 * 1024;
constexpr size_t WE_PW = WE_GLU + 2 * 262144;
constexpr size_t WE_EVOUT = WE_PW + 2 * 262144;
constexpr size_t WE_ODIN = WE_EVOUT + 2 * 1048576;
constexpr size_t WE_CK1 = WE_ODIN + 2 * 2816 * 1024;
constexpr size_t WE_CV1 = WE_CK1 + 2 * 524288;
constexpr size_t WE_CK2 = WE_CV1 + 2 * 524288;
constexpr size_t WE_CV2 = WE_CK2 + 2 * 32768;
constexpr size_t WE_UQ = WE_CV2 + 2 * 32768;
constexpr size_t WE_UKV = WE_UQ + 2 * 196608;
constexpr size_t WE_ODOUT = WE_UKV + 2 * 131072;
constexpr size_t WE_END = WE_ODOUT + 2 * 1048576;
static_assert(WE_END * 2 <= 48 * MBY, "weights overflow");

struct Params {
  const float *x, *p; const int* pos;
  const float *pre_norm, *post_norm, *ple_gate, *ple_proj;
  const float *ev_w_in, *lam_re, *lam_im, *b_re, *b_im, *c_re, *c_im, *s5_d, *log_step, *w_glu, *b_glu;
  const float *w_dw, *b_dw, *ln_g, *ln_b, *w_pw, *ev_w_out;
  const float *od_w_in, *pos_k, *pos_v, *ck_w1, *ck_w2, *cv_w1, *cv_w2, *q_norm, *kv_norm, *w_uq, *w_ukv, *od_w_out;
  float* out; char* ws;
  int phase_lo, phase_hi, coop, pad0;
};

typedef const __attribute__((address_space(4))) Params* KP;
DEV int ltid() { int t = threadIdx.x; asm volatile("" : "+v"(t)); return t; }
DEV float bf2f(bf16_t b) { return __uint_as_float(((uint32_t)b) << 16); }
typedef float f32x2_ __attribute__((ext_vector_type(2)));
typedef __bf16 bf16x2_ __attribute__((ext_vector_type(2)));
DEV uint32_t pk2(float lo, float hi) { f32x2_ v = {lo, hi}; bf16x2_ b = __builtin_convertvector(v, bf16x2_); return __builtin_bit_cast(uint32_t, b); }
DEV bf16_t f2bf(float f) { return (bf16_t)(pk2(f, 0.f) & 0xffff); }
DEV float lo2f(uint32_t u) { return __uint_as_float(u << 16); }
DEV float hi2f(uint32_t u) { return __uint_as_float(u & 0xffff0000u); }
DEV float fexp2(float x) { return __builtin_amdgcn_exp2f(x); }
DEV float frcp(float x) { return __builtin_amdgcn_rcpf(x); }
DEV float sigmoidf_(float x) { return frcp(1.f + fexp2(-x * LOG2E)); }
DEV float siluf_(float x) { return x * sigmoidf_(x); }
DEV float gelu_tanh(float x) { float u = 1.5957691216057308f * (x + 0.044715f * x * x * x); return x * sigmoidf_(u); }
DEV f32x4 mfma16(bf16x8 a, bf16x8 b, f32x4 c) { return __builtin_amdgcn_mfma_f32_16x16x32_bf16(a, b, c, 0, 0, 0); }
DEV bf16x8 ld8(const bf16_t* p) { return *reinterpret_cast<const bf16x8*>(p); }
DEV bf16x8 as_bf16x8(uint4 v) { union { uint4 u; bf16x8 b; } c; c.u = v; return c.b; }

DEV void fsincos_q(float x, float xe, float& s, float& c) {
  const float k = rintf(x * 0.63661977236758134f);
  float r = fmaf(-k, 1.5703125f, x);
  r = fmaf(-k, 4.837512969970703125e-4f, r);
  r = fmaf(-k, 7.54978995489188216e-8f, r);
  r += xe;
  const int q = ((int)k) & 3;
  const float r2 = r * r;
  const float sp = fmaf(r * r2, fmaf(r2, fmaf(r2, fmaf(r2, 2.7557319e-6f, -1.98412698e-4f), 8.33333333e-3f), -1.66666667e-1f), r);
  const float cp = fmaf(r2, fmaf(r2, fmaf(r2, fmaf(r2, fmaf(r2, -2.75573192e-7f, 2.48015873e-5f), -1.38888889e-3f), 4.16666667e-2f), -0.5f), 1.0f);
  if (q == 0) { s = sp; c = cp; } else if (q == 1) { s = cp; c = -sp; } else if (q == 2) { s = -sp; c = -cp; } else { s = -cp; c = sp; }
}
DEV float rope_freq(int i) {
  int r = i & 3, q = i >> 2;
  float f = r == 0 ? 1.0f : (r == 1 ? 0.5623413251903491f : (r == 2 ? 0.31622776601683794f : 0.1778279410038923f));
  float s = q == 0 ? 1.0f : (q == 1 ? 0.1f : (q == 2 ? 0.01f : 0.001f));
  return f * s;
}
DEV f32x4 rope4(f32x4 v, const float2* tab, int m, int i0) {
  const float4 cs = *(const float4*)(tab + (size_t)m * 16 + i0);
  f32x4 o;
  o[0] = v[0] * cs.x - v[1] * cs.y; o[1] = v[0] * cs.y + v[1] * cs.x;
  o[2] = v[2] * cs.z - v[3] * cs.w; o[3] = v[2] * cs.w + v[3] * cs.z;
  return o;
}

DEV int swz(int row, int c) { return row * 128 + ((c ^ ((row >> 1) & 7)) << 4); }

DEV int swz32(int row, int c) { return row * 64 + ((c ^ ((0x1320 >> (((row >> 2) & 3) * 4)) & 3)) << 4); }
template <bool STAGED = false, typename AROW, typename EPI>
DEV void gemm128(AROW arow, int a_kstep, const bf16_t* __restrict__ Bt, int ldb, int m0, int n0, int K, char* lds, EPI epi,
                 bf16_t* dst0 = nullptr, int ld0 = 0, bf16_t* dst1 = nullptr, int ld1 = 0) {
  int tid_ = threadIdx.x; asm volatile("" : "+v"(tid_));
  const int tid = tid_, lane = tid & 63, wid = tid >> 6;
  const int wr = wid >> 1, wc = wid & 1;
  const int lr = tid >> 2, lcs = (tid & 3) ^ ((0x1320 >> (((tid >> 4) & 3) * 4)) & 3);
  const bf16_t* ap[2]; const bf16_t* bp[2];
#pragma unroll
  for (int i = 0; i < 2; ++i) { ap[i] = arow(m0 + lr + 64 * i) + lcs * 8; bp[i] = Bt + (size_t)(n0 + lr + 64 * i) * ldb + lcs * 8; }
  f32x4 acc[4][4];
#pragma unroll
  for (int i = 0; i < 4; ++i)
#pragma unroll
    for (int j = 0; j < 4; ++j) acc[i][j] = (f32x4){0.f, 0.f, 0.f, 0.f};
  const int nk = K >> 5;
  const int fr = lane & 15, fq = lane >> 4;
  auto issue = [&](int kt) {
    char* buf = lds + (kt & 3) * 16384 + tid * 16;
    const size_t ka = (size_t)(kt >> 1) * a_kstep + (kt & 1) * 32, kb = (size_t)kt * 32;
#pragma unroll
    for (int i = 0; i < 2; ++i) {
      __builtin_amdgcn_global_load_lds((const unsigned*)(ap[i] + ka), (unsigned*)(buf + i * 4096), 16, 0, 0);
      __builtin_amdgcn_global_load_lds((const unsigned*)(bp[i] + kb), (unsigned*)(buf + 8192 + i * 4096), 16, 0, 0);
    }
  };
  const uint32_t lds32 = (uint32_t)(size_t)(LAS3 char*)lds;
  const uint32_t aoff = swz32(wr * 64 + fr, fq), boff = 8192 + swz32(wc * 64 + fr, fq);
  auto issue1 = [&](int kt, int piece) {
    char* buf = lds + (kt & 3) * 16384 + tid * 16;
    if (piece < 2) __builtin_amdgcn_global_load_lds((const unsigned*)(ap[piece] + (size_t)(kt >> 1) * a_kstep + (kt & 1) * 32), (unsigned*)(buf + piece * 4096), 16, 0, 0);
    else __builtin_amdgcn_global_load_lds((const unsigned*)(bp[piece - 2] + (size_t)kt * 32), (unsigned*)(buf + 8192 + (piece - 2) * 4096), 16, 0, 0);
  };
  auto wait_vm = [&](int n) {
    if (n >= 3) asm volatile("s_waitcnt vmcnt(12)" ::: "memory");
    else if (n == 2) asm volatile("s_waitcnt vmcnt(8)" ::: "memory");
    else if (n == 1) asm volatile("s_waitcnt vmcnt(4)" ::: "memory");
    else asm volatile("s_waitcnt vmcnt(0)" ::: "memory");
  };
#define GEMM_RD(FA, FB, KT) do { const uint32_t aaddr_ = lds32 + ((KT) & 3) * 16384 + aoff, baddr_ = lds32 + ((KT) & 3) * 16384 + boff; \
    asm volatile("ds_read_b128 %0, %1" : "=v"(FA[0]) : "v"(aaddr_)); \
    asm volatile("ds_read_b128 %0, %1 offset:1024" : "=v"(FA[1]) : "v"(aaddr_)); \
    asm volatile("ds_read_b128 %0, %1 offset:2048" : "=v"(FA[2]) : "v"(aaddr_)); \
    asm volatile("ds_read_b128 %0, %1 offset:3072" : "=v"(FA[3]) : "v"(aaddr_)); \
    asm volatile("ds_read_b128 %0, %1" : "=v"(FB[0]) : "v"(baddr_)); \
    asm volatile("ds_read_b128 %0, %1 offset:1024" : "=v"(FB[1]) : "v"(baddr_)); \
    asm volatile("ds_read_b128 %0, %1 offset:2048" : "=v"(FB[2]) : "v"(baddr_)); \
    asm volatile("ds_read_b128 %0, %1 offset:3072" : "=v"(FB[3]) : "v"(baddr_)); } while (0)
#define GEMM_LGKM0(FA, FB) asm volatile("s_waitcnt lgkmcnt(0)" : "+v"(FA[0]), "+v"(FA[1]), "+v"(FA[2]), "+v"(FA[3]), "+v"(FB[0]), "+v"(FB[1]), "+v"(FB[2]), "+v"(FB[3]))
#define GEMM_STEP(KT, CA, CB, NA, NB) do { \
    if ((KT) + 1 < nk) { \
      int y_ = nk - (KT) - 2; wait_vm(y_ > 2 ? 2 : y_); \
      __builtin_amdgcn_s_barrier(); \
      GEMM_RD(NA, NB, (KT) + 1); \
    } \
    const bool doiss_ = (KT) + 4 < nk; \
    _Pragma("unroll") for (int mi = 0; mi < 4; ++mi) { \
      _Pragma("unroll") for (int ni = 0; ni < 4; ++ni) acc[mi][ni] = mfma16(CB[ni], CA[mi], acc[mi][ni]); \
      if (doiss_) issue1((KT) + 4, mi); \
      __builtin_amdgcn_sched_barrier(0); \
    } \
    if ((KT) + 1 < nk) GEMM_LGKM0(NA, NB); } while (0)
  asm volatile("s_waitcnt vmcnt(0)" ::: "memory");
  __syncthreads();
  issue(0);
  if (nk > 1) issue(1);
  if (nk > 2) issue(2);
  if (nk > 3) issue(3);
  bf16x8 fa0[4], fb0[4], fa1[4], fb1[4];
  wait_vm(nk - 1 > 3 ? 3 : nk - 1);
  __builtin_amdgcn_s_barrier();
  GEMM_RD(fa0, fb0, 0);
  GEMM_LGKM0(fa0, fb0);
  for (int kt = 0; kt < nk; kt += 2) {
    GEMM_STEP(kt, fa0, fb0, fa1, fb1);
    if (kt + 1 < nk) GEMM_STEP(kt + 1, fa1, fb1, fa0, fb0);
  }
  __syncthreads();
  if constexpr (!STAGED) {
#pragma unroll
    for (int mi = 0; mi < 4; ++mi)
#pragma unroll
      for (int ni = 0; ni < 4; ++ni) epi(m0 + wr * 64 + mi * 16 + fr, n0 + wc * 64 + ni * 16 + fq * 4, acc[mi][ni], mi, ni);
  } else {
    char* wb = lds + wid * 9216;
#pragma unroll
    for (int mi = 0; mi < 4; ++mi)
#pragma unroll
      for (int ni = 0; ni < 4; ++ni) {
        const f32x4 v = epi(m0 + wr * 64 + mi * 16 + fr, n0 + wc * 64 + ni * 16 + fq * 4, acc[mi][ni], mi, ni);
        uint2 w; w.x = pk2(v[0], v[1]); w.y = pk2(v[2], v[3]);
        *(uint2*)(wb + (mi * 16 + fr) * 144 + (ni * 16 + fq * 4) * 2) = w;
      }
    __builtin_amdgcn_wave_barrier();
    asm volatile("s_waitcnt lgkmcnt(0)" ::: "memory");
    const int rr = lane >> 3, ch = lane & 7;
    bf16_t* db = wc ? dst1 : dst0; const int ldd = wc ? ld1 : ld0;
    bf16_t* dp = db + (size_t)(m0 + wr * 64 + rr) * ldd + ch * 8;
#pragma unroll
    for (int it = 0; it < 8; ++it) {
      const u32x4 v = *(const u32x4*)(wb + (it * 8 + rr) * 144 + ch * 16);
      *(u32x4*)(dp + (size_t)it * 8 * ldd) = v;
    }
  }
}

template <bool STAGED, typename AROW, typename EPI>
DEV void gemm256(AROW arow, int a_kstep, const bf16_t* __restrict__ Bt, int ldb, int m0, int n0, int K, char* lds, EPI epi, bf16_t* dst = nullptr, int ldd = 0) {
  int tid_ = threadIdx.x; asm volatile("" : "+v"(tid_));
  const int tid = tid_, lane = tid & 63, wid = tid >> 6;
  const int wr = wid >> 1, wc = wid & 1;
  const int lr = tid >> 2, lcs = (tid & 3) ^ ((0x1320 >> (((tid >> 4) & 3) * 4)) & 3);
  const bf16_t* ap[4]; const bf16_t* bp[2];
#pragma unroll
  for (int i = 0; i < 4; ++i) ap[i] = arow(m0 + lr + 64 * i) + lcs * 8;
#pragma unroll
  for (int i = 0; i < 2; ++i) bp[i] = Bt + (size_t)(n0 + lr + 64 * i) * ldb + lcs * 8;
  f32x4 acc[8][4];
#pragma unroll
  for (int i = 0; i < 8; ++i)
#pragma unroll
    for (int j = 0; j < 4; ++j) acc[i][j] = (f32x4){0.f, 0.f, 0.f, 0.f};
  const int nk = K >> 5;
  const int fr = lane & 15, fq = lane >> 4;
  const uint32_t lds32 = (uint32_t)(size_t)(LAS3 char*)lds;
  const uint32_t aoff = swz32(wr * 128 + fr, fq), boff = 16384 + swz32(wc * 64 + fr, fq);
  auto issue1 = [&](int kt, int slot, int piece) {
    char* buf = lds + slot * 24576 + tid * 16;
    if (piece < 4) __builtin_amdgcn_global_load_lds((const unsigned*)(ap[piece] + (size_t)(kt >> 1) * a_kstep + (kt & 1) * 32), (unsigned*)(buf + piece * 4096), 16, 0, 0);
    else __builtin_amdgcn_global_load_lds((const unsigned*)(bp[piece - 4] + (size_t)kt * 32), (unsigned*)(buf + 16384 + (piece - 4) * 4096), 16, 0, 0);
  };
  asm volatile("s_waitcnt vmcnt(0)" ::: "memory");
  __syncthreads();
#pragma unroll
  for (int p = 0; p < 6; ++p) issue1(0, 0, p);
  if (nk > 1) {
#pragma unroll
    for (int p = 0; p < 6; ++p) issue1(1, 1, p);
  }
  int sc = 0;
  for (int kt = 0; kt < nk; ++kt) {
    if (kt + 1 < nk) asm volatile("s_waitcnt vmcnt(6)" ::: "memory"); else asm volatile("s_waitcnt vmcnt(0)" ::: "memory");
    __builtin_amdgcn_s_barrier();
    const uint32_t aaddr = lds32 + sc * 24576 + aoff, baddr = lds32 + sc * 24576 + boff;
    bf16x8 fa[8], fb[4];
    asm volatile("ds_read_b128 %0, %1" : "=v"(fa[0]) : "v"(aaddr));
    asm volatile("ds_read_b128 %0, %1 offset:1024" : "=v"(fa[1]) : "v"(aaddr));
    asm volatile("ds_read_b128 %0, %1 offset:2048" : "=v"(fa[2]) : "v"(aaddr));
    asm volatile("ds_read_b128 %0, %1 offset:3072" : "=v"(fa[3]) : "v"(aaddr));
    asm volatile("ds_read_b128 %0, %1 offset:4096" : "=v"(fa[4]) : "v"(aaddr));
    asm volatile("ds_read_b128 %0, %1 offset:5120" : "=v"(fa[5]) : "v"(aaddr));
    asm volatile("ds_read_b128 %0, %1 offset:6144" : "=v"(fa[6]) : "v"(aaddr));
    asm volatile("ds_read_b128 %0, %1 offset:7168" : "=v"(fa[7]) : "v"(aaddr));
    asm volatile("ds_read_b128 %0, %1" : "=v"(fb[0]) : "v"(baddr));
    asm volatile("ds_read_b128 %0, %1 offset:1024" : "=v"(fb[1]) : "v"(baddr));
    asm volatile("ds_read_b128 %0, %1 offset:2048" : "=v"(fb[2]) : "v"(baddr));
    asm volatile("ds_read_b128 %0, %1 offset:3072" : "=v"(fb[3]) : "v"(baddr));
    asm volatile("s_waitcnt lgkmcnt(0)" : "+v"(fa[0]), "+v"(fa[1]), "+v"(fa[2]), "+v"(fa[3]), "+v"(fa[4]), "+v"(fa[5]), "+v"(fa[6]), "+v"(fa[7]), "+v"(fb[0]), "+v"(fb[1]), "+v"(fb[2]), "+v"(fb[3]));
    const bool doiss = kt + 2 < nk;
    const int s2 = (sc == 0) ? 2 : sc - 1;
#pragma unroll
    for (int mi = 0; mi < 8; ++mi) {
#pragma unroll
      for (int ni = 0; ni < 4; ++ni) acc[mi][ni] = mfma16(fb[ni], fa[mi], acc[mi][ni]);
      if (mi < 6 && doiss) issue1(kt + 2, s2, mi);
      __builtin_amdgcn_sched_barrier(0);
    }
    sc = (sc == 2) ? 0 : sc + 1;
  }
  __syncthreads();
  if constexpr (!STAGED) {
#pragma unroll
    for (int mi = 0; mi < 8; ++mi)
#pragma unroll
      for (int ni = 0; ni < 4; ++ni) epi(m0 + wr * 128 + mi * 16 + fr, n0 + wc * 64 + ni * 16 + fq * 4, acc[mi][ni], mi, ni);
  } else {
    char* wb = lds + wid * 18432;
#pragma unroll
    for (int mi = 0; mi < 8; ++mi)
#pragma unroll
      for (int ni = 0; ni < 4; ++ni) {
        const f32x4 v = epi(m0 + wr * 128 + mi * 16 + fr, n0 + wc * 64 + ni * 16 + fq * 4, acc[mi][ni], mi, ni);
        uint2 w; w.x = pk2(v[0], v[1]); w.y = pk2(v[2], v[3]);
        *(uint2*)(wb + (mi * 16 + fr) * 144 + (ni * 16 + fq * 4) * 2) = w;
      }
    __builtin_amdgcn_wave_barrier();
    asm volatile("s_waitcnt lgkmcnt(0)" ::: "memory");
    const int rr = lane >> 3, ch = lane & 7;
    bf16_t* dp = dst + (size_t)(m0 + wr * 128 + rr) * ldd + n0 + wc * 64 + ch * 8;
#pragma unroll
    for (int it = 0; it < 16; ++it) {
      const u32x4 v = *(const u32x4*)(wb + (it * 8 + rr) * 144 + ch * 16);
      *(u32x4*)(dp + (size_t)it * 8 * ldd) = v;
    }
  }
}
DEV bool xcd_tile256(int L, int x, int NT, int GW, int& mt, int& nt) {
  if (L >= 8 * NT) return false;
  const int gs = 8 * GW; const int ng = L / gs, rem = L - ng * gs; const int ml = rem / GW;
  mt = ml * 8 + x; nt = ng * GW + (rem - ml * GW); return true;
}

DEV void st_bf16x4(bf16_t* p, f32x4 v) { uint2 w; w.x = pk2(v[0], v[1]); w.y = pk2(v[2], v[3]); *(uint2*)p = w; }
DEV f32x4 ld_bf16x4(const bf16_t* p) { uint2 w = *(const uint2*)p; return (f32x4){lo2f(w.x), hi2f(w.x), lo2f(w.y), hi2f(w.y)}; }

struct PrepJob { const float* src; bf16_t* dst; const float* gain; int K, Nsrc, Npad, perm; };

DEV PrepJob get_job(KP P, int jid) {
  bf16_t* W = (bf16_t*)(P->ws + OFF_W);
  PrepJob j; j.gain = nullptr; j.perm = 0;
  if (jid < 4) { j.src = P->ple_gate + (size_t)jid * 1048576; j.dst = W + WE_GATE + (size_t)jid * 1048576; j.K = 1024; j.Nsrc = 1024; j.Npad = 1024; return j; }
  jid -= 4;
  if (jid < 4) { j.src = P->ple_proj + (size_t)jid * 262144; j.dst = W + WE_PPROJ + (size_t)jid * 262144; j.K = 256; j.Nsrc = 1024; j.Npad = 1024; return j; }
  jid -= 4;
  const int l = jid & 1; const int t = jid >> 1;
  switch (t) {
    case 0: j.src = P->ev_w_in + (size_t)l * 1024 * 2560; j.dst = W + WE_EVIN + (size_t)l * 2560 * 1024; j.K = 1024; j.Nsrc = 2560; j.Npad = 2560; j.gain = P->pre_norm + (2 * l) * 1024; break;
    case 1: j.src = P->w_glu + (size_t)l * 262144; j.dst = W + WE_GLU + (size_t)l * 262144; j.K = 512; j.Nsrc = 512; j.Npad = 512; break;
    case 2: j.src = P->w_pw + (size_t)l * 262144; j.dst = W + WE_PW + (size_t)l * 262144; j.K = 512; j.Nsrc = 512; j.Npad = 512; break;
    case 3: j.src = P->ev_w_out + (size_t)l * 1048576; j.dst = W + WE_EVOUT + (size_t)l * 1048576; j.K = 1024; j.Nsrc = 1024; j.Npad = 1024; break;
    case 4: j.src = P->od_w_in + (size_t)l * 1024 * 2744; j.dst = W + WE_ODIN + (size_t)l * 2816 * 1024; j.K = 1024; j.Nsrc = 2744; j.Npad = 2816; j.gain = P->pre_norm + (2 * l + 1) * 1024; j.perm = 1; break;
    case 5: j.src = P->ck_w1 + (size_t)l * 524288; j.dst = W + WE_CK1 + (size_t)l * 524288; j.K = 2048; j.Nsrc = 256; j.Npad = 256; break;
    case 6: j.src = P->cv_w1 + (size_t)l * 524288; j.dst = W + WE_CV1 + (size_t)l * 524288; j.K = 2048; j.Nsrc = 256; j.Npad = 256; break;
    case 7: j.src = P->ck_w2 + (size_t)l * 16384; j.dst = W + WE_CK2 + (size_t)l * 32768; j.K = 256; j.Nsrc = 64; j.Npad = 64; break;
    case 8: j.src = P->cv_w2 + (size_t)l * 16384; j.dst = W + WE_CV2 + (size_t)l * 32768; j.K = 256; j.Nsrc = 64; j.Npad = 64; break;
    case 9: j.src = P->w_uq + (size_t)l * 196608; j.dst = W + WE_UQ + (size_t)l * 196608; j.K = 256; j.Nsrc = 768; j.Npad = 768; j.gain = P->q_norm + l * 256; j.perm = 2; break;
    case 10: j.src = P->w_ukv + (size_t)l * 131072; j.dst = W + WE_UKV + (size_t)l * 131072; j.K = 128; j.Nsrc = 1024; j.Npad = 1024; j.gain = P->kv_norm + l * 128; break;
    default: j.src = P->od_w_out + (size_t)l * 1048576; j.dst = W + WE_ODOUT + (size_t)l * 1048576; j.K = 1024; j.Nsrc = 1024; j.Npad = 1024; break;
  }
  return j;
}
constexpr int N_PREP_JOBS = 8 + 24;

DEV int perm_col(int perm, int n) {
  if (perm == 1) {
    if (n < 1280) return n;
    if (n < 2176) return n + 24;
    if (n < 2208) { int i = n - 2176; return 2200 + ((i & 1) * 16 + (i >> 1)); }
    if (n < 2720) return n + 24;
    if (n < 2744) return 1280 + (n - 2720);
    return -1;
  }
  if (perm == 2) {
    int h = n / 96, c = n - h * 96;
    if (c < 64) return n;
    int i = c - 64; return h * 96 + 64 + ((i & 1) * 16 + (i >> 1));
  }
  return n;
}

__device__ void prep_tile(const PrepJob& j, int tile, char* lds) {
  float* tl = (float*)lds;
  const int ntn = j.Npad >> 6;
  const int kt = tile / ntn, nt = tile - kt * ntn;
  const int k0 = kt * 64, n0 = nt * 64;
  int tid_ = threadIdx.x; asm volatile("" : "+v"(tid_));
  const int tid = tid_, tx = tid & 63, ty = tid >> 6;
  const int sc = perm_col(j.perm, n0 + tx);
  __syncthreads();
#pragma unroll
  for (int r = 0; r < 16; ++r) {
    const int k = k0 + ty * 16 + r;
    float v = 0.f;
    if (sc >= 0) { v = j.src[(size_t)k * j.Nsrc + sc]; if (j.gain) v *= j.gain[k]; }
    tl[(ty * 16 + r) * 65 + tx] = v;
  }
  __syncthreads();
  const int nl = tid >> 2, ks = (tid & 3) * 16;
  uint32_t w[8];
#pragma unroll
  for (int i = 0; i < 8; ++i) w[i] = pk2(tl[(ks + 2 * i) * 65 + nl], tl[(ks + 2 * i + 1) * 65 + nl]);
  bf16_t* d = j.dst + (size_t)(n0 + nl) * j.K + k0 + ks;
  *(uint4*)d = make_uint4(w[0], w[1], w[2], w[3]);
  *(uint4*)(d + 8) = make_uint4(w[4], w[5], w[6], w[7]);
}

__device__ void prep_tile4(const PrepJob& j, int tile, char* lds) {
  float* tl = (float*)lds;
  const int ntn = j.Npad >> 8;
  const int kt = tile / ntn, nq = tile - kt * ntn;
  const int k0 = kt * 64, n0 = nq * 256;
  int tid_ = threadIdx.x; asm volatile("" : "+v"(tid_));
  const int tid = tid_, tx = tid & 63, ty = tid >> 6;
  float v[4][16];
#pragma unroll
  for (int w = 0; w < 4; ++w) {
    const int sc = perm_col(j.perm, n0 + w * 64 + tx);
    const float* sp = j.src + (size_t)(k0 + ty * 16) * j.Nsrc + (sc >= 0 ? sc : 0);
#pragma unroll
    for (int r = 0; r < 16; ++r) { const float t = sp[(size_t)r * j.Nsrc]; v[w][r] = (sc >= 0) ? t : 0.f; }
  }
  float g[16];
#pragma unroll
  for (int r = 0; r < 16; ++r) g[r] = j.gain ? j.gain[k0 + ty * 16 + r] : 1.0f;
  __syncthreads();
#pragma unroll
  for (int w = 0; w < 4; ++w)
#pragma unroll
    for (int r = 0; r < 16; ++r) tl[w * 4160 + (ty * 16 + r) * 65 + tx] = v[w][r] * g[r];
  __syncthreads();
  const int nl = tid >> 2, ks = (tid & 3) * 16;
#pragma unroll
  for (int w = 0; w < 4; ++w) {
    uint32_t pw[8];
#pragma unroll
    for (int i = 0; i < 8; ++i) pw[i] = pk2(tl[w * 4160 + (ks + 2 * i) * 65 + nl], tl[w * 4160 + (ks + 2 * i + 1) * 65 + nl]);
    bf16_t* d = j.dst + (size_t)(n0 + w * 64 + nl) * j.K + k0 + ks;
    *(uint4*)d = make_uint4(pw[0], pw[1], pw[2], pw[3]);
    *(uint4*)(d + 8) = make_uint4(pw[4], pw[5], pw[6], pw[7]);
  }
}
__device__ void phase_prologue(KP P, char* lds) {
  const int tid = ltid(), lane = tid & 63, wid = tid >> 6;
  const int G = gridDim.x, bid = blockIdx.x;
  int base = 0;
  for (int jid = 0; jid < N_PREP_JOBS; ++jid) {
    PrepJob j = get_job(P, jid);
    const bool wide = (j.Npad & 255) == 0;
    const int nt = (j.K >> 6) * (wide ? (j.Npad >> 8) : (j.Npad >> 6));
    int start = (bid - (base % G) + G) % G;
    for (int t = start; t < nt; t += G) { if (wide) prep_tile4(j, t, lds); else prep_tile(j, t, lds); }
    base += nt;
  }
  {
    bf16_t* hb2 = (bf16_t*)(P->ws + OFF_HB2);
    float* rspre = (float*)(P->ws + OFF_MV);
    for (int row = bid * 4 + wid; row < T_TOK; row += G * 4) {
      const float* xr = P->x + (size_t)row * DM;
      float ss = 0.f;
#pragma unroll
      for (int i = 0; i < 4; ++i) {
        float4 v = *(const float4*)(xr + i * 256 + lane * 4);
        ss += v.x * v.x + v.y * v.y + v.z * v.z + v.w * v.w;
        uint2 w; w.x = pk2(v.x, v.y); w.y = pk2(v.z, v.w);
        *(uint2*)(hb2 + (size_t)row * DM + i * 256 + lane * 4) = w;
      }
#pragma unroll
      for (int o = 32; o > 0; o >>= 1) ss += __shfl_xor(ss, o);
      if (lane < 16) rspre[(size_t)row * 16 + lane] = (lane == 0) ? ss : 0.f;
    }
  }
  {
    float4* s5a = (float4*)(P->ws + OFF_S5A);
    for (int idx = bid * NTHREADS + tid; idx < 2 * 32 * 64; idx += G * NTHREADS) {
      const int j = idx >> 11, g = (idx >> 6) & 31;
      const float step = expf(P->log_step[j * 32 + g]);
      const float lr = P->lam_re[idx], li = P->lam_im[idx];
      const float zr = lr * step;
      const float th = li * step, the = fmaf(li, step, -th);
      const float em1 = zr * fmaf(zr, fmaf(zr, fmaf(zr, fmaf(zr, fmaf(zr, 1.98412698e-4f, 1.38888889e-3f), 8.33333333e-3f), 4.16666667e-2f), 1.66666667e-1f), 0.5f) * zr + zr;
      const float mag = 1.0f + em1;
      float sn, cs; fsincos_q(th, the, sn, cs);
      float sh, ch; fsincos_q(0.5f * th, 0.5f * the, sh, ch);
      const float ar = mag * cs, ai = mag * sn;
      const float magL = expf(64.0f * zr); float snL, csL; fsincos_q(64.0f * th, 64.0f * the, snL, csL);
      s5a[idx] = make_float4(ar, ai, magL * csL, magL * snL);
      const float den = lr * lr + li * li;
      const float nr = em1 * cs - 2.0f * sh * sh, ni = ai;
      const float fr = (nr * lr + ni * li) / den, fi = (ni * lr - nr * li) / den;
      bf16_t* bbT = (bf16_t*)(P->ws + OFF_BBR);
      const size_t rb = ((size_t)(idx >> 6) * 128 + (idx & 63)) * 16;
      for (int c = 0; c < 16; ++c) {
        const float br = P->b_re[(size_t)idx * 16 + c], bi = P->b_im[(size_t)idx * 16 + c];
        bbT[rb + c] = f2bf(fr * br - fi * bi);
        bbT[rb + 64 * 16 + c] = f2bf(fr * bi + fi * br);
      }
    }
    bf16_t* cm = (bf16_t*)(P->ws + OFF_CM);
    for (int idx = bid * NTHREADS + tid; idx < 2 * 32 * 16 * 128; idx += G * NTHREADS) {
      const int k = idx & 127, jgc = idx >> 7;
      float v = (k < 64) ? P->c_re[(size_t)jgc * 64 + k] : -P->c_im[(size_t)jgc * 64 + (k - 64)];
      cm[idx] = f2bf(v);
    }
  }
  {
    float2* tab = (float2*)(P->ws + OFF_ROPE);
    for (int idx = bid * NTHREADS + tid; idx < T_TOK * 16; idx += G * NTHREADS) {
      const int tok = idx >> 4, i = idx & 15;
      const float ang = (float)P->pos[tok] * rope_freq(i);
      float sn, cs; fsincos_q(ang, 0.f, sn, cs);
      tab[idx] = make_float2(cs, sn);
    }
  }
  {
    float* part = (float*)(P->ws + OFF_HID);
    for (int u = bid; u < 128; u += G) {
      const int jk = u >> 5, sl = u & 31; const int j = jk >> 1, kv = jk & 1;
      const float* pos = (kv ? P->pos_v : P->pos_k) + j * 2048 + sl * 64;
      const float* w1 = (kv ? P->cv_w1 : P->ck_w1) + (size_t)j * 524288 + (size_t)sl * 64 * 256 + tid;
      float s = 0.f;
#pragma unroll 16
      for (int k = 0; k < 64; ++k) s += pos[k] * w1[(size_t)k * 256];
      part[(size_t)u * 256 + tid] = s;
    }
  }
  {
    bf16_t* kc = (bf16_t*)(P->ws + OFF_KC); bf16_t* vc = (bf16_t*)(P->ws + OFF_VC);
    for (int idx = bid * NTHREADS + tid; idx < 8 * 128; idx += G * NTHREADS) {
      const int b = idx >> 7, e = idx & 127;
      kc[(size_t)(b * 128 + 127) * 128 + e] = 0; vc[(size_t)(b * 128 + 127) * 128 + e] = 0;
    }
  }
}

__device__ void convert_p(KP P, int layer) {
  const float* src = P->p + (size_t)layer * T_TOK * 256;
  bf16_t* pb = (bf16_t*)(P->ws + OFF_PB);
  const int tidc = ltid();
  for (size_t i = (size_t)blockIdx.x * NTHREADS + tidc; i < (size_t)T_TOK * 256 / 8; i += (size_t)gridDim.x * NTHREADS) {
    float4 a = *(const float4*)(src + i * 8), b = *(const float4*)(src + i * 8 + 4);
    *(uint4*)(pb + i * 8) = make_uint4(pk2(a.x, a.y), pk2(a.z, a.w), pk2(b.x, b.y), pk2(b.z, b.w));
  }
}

DEV bool xcd_tile(int L, int x, int NT, int GW, int& mt, int& nt) {
  if (L >= 16 * NT) return false;
  const int gs = 16 * GW; const int ng = L / gs, rem = L - ng * gs; const int ml = rem / GW;
  mt = ml * 8 + x; nt = ng * GW + (rem - ml * GW); return true;
}
__device__ void phase_win(KP P, int layer, char* lds) {
  const bool odd = layer & 1; const int j = layer >> 1;
  const bf16_t* W = (const bf16_t*)(P->ws + OFF_W);
  const bf16_t* Bt = odd ? W + WE_ODIN + (size_t)j * 2816 * 1024 : W + WE_EVIN + (size_t)j * 2560 * 1024;
  const int NT = odd ? 22 : 20;
  const bf16_t* hb2 = (const bf16_t*)(P->ws + OFF_HB2);
  bf16_t* proj = (bf16_t*)(P->ws + OFF_PROJ);
  const float* rspre = (const float*)(P->ws + OFF_MV);
  float* gl = (float*)(P->ws + OFF_GL);
  bf16_t* mk = (bf16_t*)(P->ws + OFF_MK);
  for (int L = blockIdx.x >> 3; ; L += gridDim.x >> 3) {
    int mt, nt; if (!xcd_tile256(L, blockIdx.x & 7, NT, NT >> 1, mt, nt)) break;
    auto arow = [&](int r) { return hb2 + (size_t)r * DM; };
    auto epi = [&](int m, int n, f32x4 v, int, int) {
      const float4* rp = (const float4*)(rspre + (size_t)m * 16);
      const float4 r0 = rp[0], r1 = rp[1], r2 = rp[2], r3 = rp[3];
      const float ssq_ = ((r0.x + r0.y) + (r0.z + r0.w)) + ((r1.x + r1.y) + (r1.z + r1.w)) + ((r2.x + r2.y) + (r2.z + r2.w)) + ((r3.x + r3.y) + (r3.z + r3.w));
      const float rstd = rsqrtf(ssq_ * (1.0f / 1024.0f) + 1e-6f);
      v = v * rstd;
      if (!odd) { st_bf16x4(proj + (size_t)m * LDP + n, v); return; }
      if (n < 512) { v = v * (0.125f * LOG2E); st_bf16x4(proj + (size_t)m * LDP + n, v); return; }
      if (n >= 2176 && n < 2208) {
        const int i0 = (n - 2176) >> 1;
        v = rope4(v, (const float2*)(P->ws + OFF_ROPE), m, i0);
        bf16_t* d = mk + (size_t)m * 768 + 64 + (n - 2176);
#pragma unroll
        for (int h = 0; h < 8; ++h) st_bf16x4(d + h * 96, v);
        return;
      }
      if (n >= 2720) { if (n < 2744) *(f32x4*)(gl + (size_t)m * 32 + (n - 2720)) = v; return; }
      st_bf16x4(proj + (size_t)m * LDP + n, v);
    };
    const bool plain = !odd || (nt != 17 && nt != 21);
    if (plain) {
      const float qs = (odd && nt < 4) ? (0.125f * LOG2E) : 1.0f;
      auto epis = [&](int m, int, f32x4 v, int, int) -> f32x4 {
        const float4* rp = (const float4*)(rspre + (size_t)m * 16);
        const float4 r0 = rp[0], r1 = rp[1], r2 = rp[2], r3 = rp[3];
        const float ssq_ = ((r0.x + r0.y) + (r0.z + r0.w)) + ((r1.x + r1.y) + (r1.z + r1.w)) + ((r2.x + r2.y) + (r2.z + r2.w)) + ((r3.x + r3.y) + (r3.z + r3.w));
        return v * (rsqrtf(ssq_ * (1.0f / 1024.0f) + 1e-6f) * qs);
      };
      gemm256<true>(arow, 64, Bt, 1024, mt * 256, nt * 128, 1024, lds, epis, proj, LDP);
    } else {
      gemm256<false>(arow, 64, Bt, 1024, mt * 256, nt * 128, 1024, lds, epi);
    }
  }
  convert_p(P, layer);
  if (layer == 0 && blockIdx.x < 4) {
    const int t_ = ltid(); const int jk = blockIdx.x;
    const float* part = (const float*)(P->ws + OFF_HID);
    float s = 0.f;
    for (int sl = 0; sl < 32; ++sl) s += part[(size_t)(jk * 32 + sl) * 256 + t_];
    ((float*)(P->ws + OFF_POSB))[jk * 256 + t_] = s;
  }
}

template <int PASS>
__device__ void s5_unit(KP P, int j, int unit, char* lds) {
  int tid_ = threadIdx.x; asm volatile("" : "+v"(tid_));
  const int tid = tid_, lane = tid & 63, wid = tid >> 6;
  const int fr = lane & 15, fq = lane >> 4;
  const int cq = unit & 7, g = (unit >> 3) & 31, b = unit >> 8;
  const int k = cq * 4 + wid; const int t0 = k * 64;
  const bf16_t* proj = (const bf16_t*)(P->ws + OFF_PROJ);
  float* st = (float*)(P->ws + OFF_MK) + ((size_t)(b * 32 + g) * 32) * 128;
  bf16_t* xs = (bf16_t*)(lds + wid * 8704);
  float* bu = (float*)(lds + 34816 + wid * 8448);
  const bf16x8 zero8 = (bf16x8){0, 0, 0, 0, 0, 0, 0, 0};
  bf16x8 uf[4], bbf[8];
  {
    const bf16_t* up = proj + (size_t)(b * SEQL + t0 + fr) * LDP + g * 16 + (fq & 1) * 8;
#pragma unroll
    for (int sb = 0; sb < 4; ++sb) { bf16x8 v = ld8(up + (size_t)sb * 16 * LDP); uf[sb] = (fq < 2) ? v : zero8; }
    const bf16_t* bp_ = (const bf16_t*)(P->ws + OFF_BBR) + ((size_t)(j * 32 + g) * 128 + fr) * 16 + (fq & 1) * 8;
#pragma unroll
    for (int ns = 0; ns < 8; ++ns) { bf16x8 v = ld8(bp_ + ns * 256); bbf[ns] = (fq < 2) ? v : zero8; }
  }
  const int pidx = (j * 32 + g) * 64 + lane;
  const float4 a4 = ((const float4*)(P->ws + OFF_S5A))[pidx];
  const float ar = a4.x, ai = a4.y;
  float xr = 0.f, xi = 0.f;
  if (PASS == 3) {
    const float aLr = a4.z, aLi = a4.w;
#pragma unroll 8
    for (int jj = 0; jj < 32; ++jj) {
      const float sr = st[jj * 128 + lane], si = st[jj * 128 + 64 + lane];
      const float nr = aLr * xr - aLi * xi + sr, ni = aLr * xi + aLi * xr + si;
      xr = (jj < k) ? nr : xr; xi = (jj < k) ? ni : xi;
    }
  }
  bf16x8 cf[4]; float4 dsk = make_float4(0.f, 0.f, 0.f, 0.f);
  if (PASS == 3) {
    const bf16_t* cm = (const bf16_t*)(P->ws + OFF_CM) + ((size_t)(j * 32 + g) * 16 + fr) * 128 + fq * 8;
#pragma unroll
    for (int kk = 0; kk < 4; ++kk) cf[kk] = ld8(cm + kk * 32);
    dsk = *(const float4*)(P->s5_d + j * 512 + g * 16 + fq * 4);
  }
  bf16_t* ya = (bf16_t*)(P->ws + OFF_HB2);
#pragma unroll 1
  for (int sb = 0; sb < 4; ++sb) {
    __syncthreads();
#pragma unroll
    for (int ns = 0; ns < 8; ++ns) {
      bf16x8 ufs = uf[0];
      ufs = (sb == 1) ? uf[1] : ufs; ufs = (sb == 2) ? uf[2] : ufs; ufs = (sb == 3) ? uf[3] : ufs;
      const f32x4 acc = mfma16(bbf[ns], ufs, (f32x4){0.f, 0.f, 0.f, 0.f});
      *(f32x4*)(bu + fr * 132 + ns * 16 + fq * 4) = acc;
    }
    __syncthreads();
#pragma unroll
    for (int t = 0; t < 16; ++t) {
      const float bur = bu[t * 132 + lane], bui = bu[t * 132 + 64 + lane];
      const float nr = ar * xr - ai * xi + bur, ni = ar * xi + ai * xr + bui;
      xr = nr; xi = ni;
      if (PASS == 3) { const int row = (sb & 1) * 16 + t; xs[row * 136 + lane] = f2bf(xr); xs[row * 136 + 64 + lane] = f2bf(xi); }
    }
    if (PASS == 3 && (sb & 1)) {
      __syncthreads();
      const int half = sb >> 1;
#pragma unroll
      for (int tt = 0; tt < 2; ++tt) {
        f32x4 acc = (f32x4){0.f, 0.f, 0.f, 0.f};
#pragma unroll
        for (int kk = 0; kk < 4; ++kk) {
          bf16x8 xf = *(const bf16x8*)(xs + (tt * 16 + fr) * 136 + kk * 32 + fq * 8);
          acc = mfma16(cf[kk], xf, acc);
        }
        const int tl = half * 32 + tt * 16 + fr;
        const f32x4 uu = ld_bf16x4(proj + (size_t)(b * SEQL + t0 + tl) * LDP + g * 16 + fq * 4);
        f32x4 y;
        y[0] = gelu_tanh(acc[0] + dsk.x * uu[0]); y[1] = gelu_tanh(acc[1] + dsk.y * uu[1]);
        y[2] = gelu_tanh(acc[2] + dsk.z * uu[2]); y[3] = gelu_tanh(acc[3] + dsk.w * uu[3]);
        st_bf16x4(ya + (size_t)(b * SEQL + t0 + tl) * 512 + g * 16 + fq * 4, y);
      }
    }
  }
  if (PASS == 1) { st[k * 128 + lane] = xr; st[k * 128 + 64 + lane] = xi; }
}

__device__ void conv_unit(KP P, int j, int unit, char* lds) {
  int tid_ = threadIdx.x; asm volatile("" : "+v"(tid_));
  const int tid = tid_, lane = tid & 63, wid = tid >> 6;
  const int b = unit >> 7, tt = unit & 127; const int t0 = tt * 16;
  const bf16_t* proj = (const bf16_t*)(P->ws + OFF_PROJ);
  bf16_t* hs = (bf16_t*)lds;
  float* red = (float*)(lds + 47104);
  __syncthreads();
#pragma unroll
  for (int bt = 0; bt < 3; ++bt) {
    u32x4 av[4], gv[4];
#pragma unroll
    for (int i = 0; i < 4; ++i) {
      const int id = tid + (bt * 4 + i) * NTHREADS;
      const int r = id >> 6, c8 = (id & 63) * 8;
      const int t = t0 - 30 + r;
      av[i] = (u32x4){0u, 0u, 0u, 0u}; gv[i] = (u32x4){0u, 0u, 0u, 0u};
      if (id < 46 * 64 && t >= 0) {
        const bf16_t* pa = proj + (size_t)(b * SEQL + t) * LDP + 1024 + c8;
        av[i] = *(const u32x4*)pa; gv[i] = *(const u32x4*)(pa + 512);
      }
    }
#pragma unroll
    for (int i = 0; i < 4; ++i) {
      const int id = tid + (bt * 4 + i) * NTHREADS;
      const int r = id >> 6, c8 = (id & 63) * 8;
      u32x4 o;
#pragma unroll
      for (int q = 0; q < 4; ++q) o[q] = pk2(lo2f(av[i][q]) * sigmoidf_(lo2f(gv[i][q])), hi2f(av[i][q]) * sigmoidf_(hi2f(gv[i][q])));
      if (id < 46 * 64) *(u32x4*)(hs + r * 512 + c8) = o;
    }
  }
  const int c0 = tid * 2;
  float w0[31], w1[31];
  const float* wp = P->w_dw + (size_t)j * 31 * 512 + c0;
#pragma unroll
  for (int kk = 0; kk < 31; ++kk) { float2 w = *(const float2*)(wp + kk * 512); w0[kk] = w.x; w1[kk] = w.y; }
  float a0[16], a1[16];
#pragma unroll
  for (int t = 0; t < 16; ++t) { a0[t] = 0.f; a1[t] = 0.f; }
  __syncthreads();
#pragma unroll
  for (int r = 0; r < 46; ++r) {
    const uint32_t hv = *(const uint32_t*)(hs + r * 512 + c0);
    const float h0 = lo2f(hv), h1 = hi2f(hv);
#pragma unroll
    for (int t = 0; t < 16; ++t) {
      const int kk = r - t;
      if (kk >= 0 && kk <= 30) { a0[t] += w0[kk] * h0; a1[t] += w1[kk] * h1; }
    }
  }
  const float2 bd = *(const float2*)(P->b_dw + j * 512 + c0);
  const float2 lg = *(const float2*)(P->ln_g + j * 512 + c0);
  const float2 lb = *(const float2*)(P->ln_b + j * 512 + c0);
  float mu[16];
#pragma unroll
  for (int t = 0; t < 16; ++t) {
    a0[t] += bd.x; a1[t] += bd.y;
    float s = a0[t] + a1[t];
#pragma unroll
    for (int o = 32; o > 0; o >>= 1) s += __shfl_xor(s, o);
    mu[t] = s;
  }
  __syncthreads();
  if (lane == 0) {
#pragma unroll
    for (int t = 0; t < 16; ++t) red[wid * 16 + t] = mu[t];
  }
  __syncthreads();
#pragma unroll
  for (int t = 0; t < 16; ++t) mu[t] = (red[t] + red[16 + t] + red[32 + t] + red[48 + t]) * (1.0f / 512.0f);
  float vr[16];
#pragma unroll
  for (int t = 0; t < 16; ++t) {
    const float d0 = a0[t] - mu[t], d1 = a1[t] - mu[t];
    float s = d0 * d0 + d1 * d1;
#pragma unroll
    for (int o = 32; o > 0; o >>= 1) s += __shfl_xor(s, o);
    vr[t] = s;
  }
  __syncthreads();
  if (lane == 0) {
#pragma unroll
    for (int t = 0; t < 16; ++t) red[wid * 16 + t] = vr[t];
  }
  __syncthreads();
  bf16_t* hc = (bf16_t*)(P->ws + OFF_HB2) + (size_t)T_TOK * 512;
#pragma unroll
  for (int t = 0; t < 16; ++t) {
    const float var = (red[t] + red[16 + t] + red[32 + t] + red[48 + t]) * (1.0f / 512.0f);
    const float rstd = rsqrtf(var + 1e-6f);
    const float y0 = siluf_((a0[t] - mu[t]) * rstd * lg.x + lb.x), y1 = siluf_((a1[t] - mu[t]) * rstd * lg.y + lb.y);
    *(uint32_t*)(hc + (size_t)(b * SEQL + t0 + t) * 512 + c0) = pk2(y0, y1);
  }
}

DEV int remap_bx(int v, int per_b) {
  if (gridDim.x != 512) return v;
  const int r = v >> 9, bid = v & 511; return (bid & 7) * per_b + (bid >> 3) + 64 * r;
}
DEV int remap_nsa(int u) {
  if (gridDim.x != 512) return u;
  const int r = u >> 9, bid = u & 511, x = bid & 7, sl = bid >> 3;
  const int grp = x + 8 * r, b = grp >> 1, hkv = grp & 1, tt = r == 0 ? 63 - sl : sl;
  return b * 128 + hkv * 64 + (b < 4 ? 63 - tt : tt);
}
DEV int remap_mla(int u) {
  if (gridDim.x != 512) return u;
  const int r = u >> 9, bid = u & 511, x = bid & 7, sl = bid >> 3;
  const int grp = x + 8 * (sl & 7), q = sl >> 3, qt = r == 0 ? 15 - q : q;
  return qt >= 8 ? (15 - qt) * 64 + grp : 512 + qt * 64 + grp;
}
__device__ void phase_even_a(KP P, int layer, char* lds) {
  const int j = layer >> 1;
  for (int u = blockIdx.x; u < 2048 + 1024; u += gridDim.x) {
    if (u < 1024) conv_unit(P, j, remap_bx(u, 128), lds); else s5_unit<1>(P, j, remap_bx(u - 1024, 256), lds);
  }
}
__device__ void phase_even_b(KP P, int layer, char* lds) {
  const int j = layer >> 1;
  const bf16_t* W = (const bf16_t*)(P->ws + OFF_W);
  const bf16_t* hc = (const bf16_t*)(P->ws + OFF_HB2) + (size_t)T_TOK * 512;
  const bf16_t* proj = (const bf16_t*)(P->ws + OFF_PROJ);
  bf16_t* mix = (bf16_t*)(P->ws + OFF_MIX);
  for (int u = blockIdx.x; u < 2048 + 512; u += gridDim.x) {
    if (u < 2048) { s5_unit<3>(P, j, remap_bx(u, 256), lds); continue; }
    const int tile = u - 2048; int mt = tile >> 2, nt = tile & 3;
    if (gridDim.x == 512) (void)xcd_tile(tile >> 3, tile & 7, 4, 4, mt, nt);
    auto arow = [&](int r) { return hc + (size_t)r * 512; };
    auto epi = [&](int m, int n, f32x4 v, int, int) -> f32x4 {
      f32x4 gb = ld_bf16x4(proj + (size_t)m * LDP + 2048 + n);
      f32x4 o;
#pragma unroll
      for (int i = 0; i < 4; ++i) o[i] = v[i] * siluf_(gb[i]);
      return o;
    };
    gemm128<true>(arow, 64, W + WE_PW + (size_t)j * 262144, 512, mt * 128, nt * 128, 512, lds, epi, mix + 512 + nt * 128, DM, mix + 512 + nt * 128 + 64, DM);
  }
}
__device__ void phase_even_c(KP P, int layer, char* lds) {
  const int j = layer >> 1;
  const bf16_t* W = (const bf16_t*)(P->ws + OFF_W);
  const bf16_t* ya = (const bf16_t*)(P->ws + OFF_HB2);
  const bf16_t* proj = (const bf16_t*)(P->ws + OFF_PROJ);
  bf16_t* mix = (bf16_t*)(P->ws + OFF_MIX);
  for (int L = blockIdx.x >> 3; ; L += gridDim.x >> 3) {
    int mt, nt; if (!xcd_tile(L, blockIdx.x & 7, 4, 4, mt, nt)) break;
    auto arow = [&](int r) { return ya + (size_t)r * 512; };
    auto epi = [&](int m, int n, f32x4 v, int, int) -> f32x4 {
      const float4 bg = *(const float4*)(P->b_glu + j * 512 + n);
      f32x4 yv = ld_bf16x4(ya + (size_t)m * 512 + n);
      f32x4 ga = ld_bf16x4(proj + (size_t)m * LDP + 512 + n);
      f32x4 o;
      o[0] = yv[0] * sigmoidf_(v[0] + bg.x) * siluf_(ga[0]); o[1] = yv[1] * sigmoidf_(v[1] + bg.y) * siluf_(ga[1]);
      o[2] = yv[2] * sigmoidf_(v[2] + bg.z) * siluf_(ga[2]); o[3] = yv[3] * sigmoidf_(v[3] + bg.w) * siluf_(ga[3]);
      return o;
    };
    gemm128<true>(arow, 64, W + WE_GLU + (size_t)j * 262144, 512, mt * 128, nt * 128, 512, lds, epi, mix + nt * 128, DM, mix + nt * 128 + 64, DM);
  }
}

__device__ void phase_out(KP P, int layer, char* lds) {
  const int j = layer >> 1;
  const bf16_t* W = (const bf16_t*)(P->ws + OFF_W);
  const bf16_t* Bt = (layer & 1) ? W + WE_ODOUT + (size_t)j * 1048576 : W + WE_EVOUT + (size_t)j * 1048576;
  const bf16_t* mix = (const bf16_t*)(P->ws + OFF_MIX);
  float* y = (float*)(P->ws + OFF_PROJ);
  float* rspost = (float*)(P->ws + OFF_HB2);
  for (int L = blockIdx.x >> 3; ; L += gridDim.x >> 3) {
    int mt, nt; if (!xcd_tile256(L, blockIdx.x & 7, 8, 8, mt, nt)) break;
    float ssq[8] = {0.f, 0.f, 0.f, 0.f, 0.f, 0.f, 0.f, 0.f};
    auto arow = [&](int r) { return mix + (size_t)r * DM; };
    auto epi = [&](int m, int n, f32x4 v, int mi, int) {
      *(f32x4*)(y + (size_t)m * DM + n) = v;
      ssq[mi] += v[0] * v[0] + v[1] * v[1] + v[2] * v[2] + v[3] * v[3];
    };
    gemm256<false>(arow, 64, Bt, 1024, mt * 256, nt * 128, 1024, lds, epi);
    const int tl_ = ltid(); const int lane = tl_ & 63, wid = tl_ >> 6;
#pragma unroll
    for (int mi = 0; mi < 8; ++mi) {
      float s = ssq[mi]; s += __shfl_xor(s, 16); s += __shfl_xor(s, 32);
      if (lane < 16) rspost[(size_t)(mt * 256 + (wid >> 1) * 128 + mi * 16 + lane) * 16 + nt * 2 + (wid & 1)] = s;
    }
  }
}
__device__ void phase_rowpass(KP P, int layer) {
  const int tl_ = ltid(); const int lane = tl_ & 63, wid = tl_ >> 6;
  const float* y = (const float*)(P->ws + OFF_PROJ);
  const float* rspost = (const float*)(P->ws + OFF_HB2);
  const float* hsrc = layer == 0 ? P->x : P->out;
  bf16_t* hb1 = (bf16_t*)(P->ws + OFF_MIX);
  const float* pg = P->post_norm + layer * DM;
  const bool xr_ = gridDim.x == 512;
  for (int it = 0; ; ++it) {
    int row;
    if (xr_) {
      if (it >= 8) break;
      const int lr = ((int)(blockIdx.x >> 3) * 4 + wid) + 256 * it;
      row = ((lr >> 7) * 8 + (int)(blockIdx.x & 7)) * 128 + (lr & 127);
    } else { row = blockIdx.x * 4 + wid + it * gridDim.x * 4; if (row >= T_TOK) break; }
    float sq = (lane < 16) ? rspost[(size_t)row * 16 + lane] : 0.f;
#pragma unroll
    for (int o = 8; o > 0; o >>= 1) sq += __shfl_xor(sq, o);
    sq = __shfl(sq, 0);
    const float rstd = rsqrtf(sq * (1.0f / 1024.0f) + 1e-6f);
#pragma unroll
    for (int i = 0; i < 4; ++i) {
      const int c = i * 256 + lane * 4;
      float4 yv = *(const float4*)(y + (size_t)row * DM + c);
      float4 hv = *(const float4*)(hsrc + (size_t)row * DM + c);
      float4 g = *(const float4*)(pg + c);
      hv.x += yv.x * rstd * g.x; hv.y += yv.y * rstd * g.y; hv.z += yv.z * rstd * g.z; hv.w += yv.w * rstd * g.w;
      uint2 w; w.x = pk2(hv.x, hv.y); w.y = pk2(hv.z, hv.w);
      *(uint2*)(hb1 + (size_t)row * DM + c) = w;
    }
  }
}
__device__ void phase_ple(KP P, int layer, char* lds) {
  const bf16_t* W = (const bf16_t*)(P->ws + OFF_W);
  const bf16_t* gate_t = W + WE_GATE + (size_t)layer * 1048576;
  const bf16_t* pproj_t = W + WE_PPROJ + (size_t)layer * 262144;
  const bf16_t* hb1 = (const bf16_t*)(P->ws + OFF_MIX);
  const bf16_t* pb = (const bf16_t*)(P->ws + OFF_PB);
  bf16_t* hb2 = (bf16_t*)(P->ws + OFF_HB2);
  float* rspre = (float*)(P->ws + OFF_MV);
  for (int L = blockIdx.x >> 3; ; L += gridDim.x >> 3) {
    int mt, nt; if (!xcd_tile(L, blockIdx.x & 7, 8, 8, mt, nt)) break;
    uint32_t stash[4][4][2];
    auto arow2 = [&](int r) { return pb + (size_t)r * 256; };
    auto epi2 = [&](int, int, f32x4 v, int mi, int ni) { stash[mi][ni][0] = pk2(v[0], v[1]); stash[mi][ni][1] = pk2(v[2], v[3]); };
    gemm128(arow2, 64, pproj_t, 256, mt * 128, nt * 128, 256, lds, epi2);
    float ssq[4] = {0.f, 0.f, 0.f, 0.f};
    auto arow = [&](int r) { return hb1 + (size_t)r * DM; };
    auto epi = [&](int m, int n, f32x4 v, int mi, int ni) -> f32x4 {
      const f32x4 t4 = ld_bf16x4(hb1 + (size_t)m * DM + n);
      float4 hv = make_float4(t4[0], t4[1], t4[2], t4[3]);
      const uint32_t s0 = stash[mi][ni][0], s1 = stash[mi][ni][1];
      hv.x += sigmoidf_(v[0]) * lo2f(s0); hv.y += sigmoidf_(v[1]) * hi2f(s0);
      hv.z += sigmoidf_(v[2]) * lo2f(s1); hv.w += sigmoidf_(v[3]) * hi2f(s1);
      *(float4*)(P->out + (size_t)m * DM + n) = hv;
      ssq[mi] += hv.x * hv.x + hv.y * hv.y + hv.z * hv.z + hv.w * hv.w;
      return (f32x4){hv.x, hv.y, hv.z, hv.w};
    };
    gemm128<true>(arow, 64, gate_t, 1024, mt * 128, nt * 128, 1024, lds, epi, hb2 + nt * 128, DM, hb2 + nt * 128 + 64, DM);
    const int tl_ = ltid(); const int lane = tl_ & 63, wid = tl_ >> 6;
#pragma unroll
    for (int mi = 0; mi < 4; ++mi) {
      float s = ssq[mi]; s += __shfl_xor(s, 16); s += __shfl_xor(s, 32);
      if (lane < 16) rspre[(size_t)(mt * 128 + (wid >> 1) * 64 + mi * 16 + lane) * 16 + nt * 2 + (wid & 1)] = s;
    }
  }
}

__device__ void phase_odd_a(KP P, int layer, char* lds) {
  const int j = layer >> 1;
  const bf16_t* W = (const bf16_t*)(P->ws + OFF_W);
  const bf16_t* proj = (const bf16_t*)(P->ws + OFF_PROJ);
  bf16_t* hid = (bf16_t*)(P->ws + OFF_HID);
  const float* posb = (const float*)(P->ws + OFF_POSB);
  bf16_t* mq = (bf16_t*)(P->ws + OFF_HB2); bf16_t* mk = (bf16_t*)(P->ws + OFF_MK); bf16_t* mv = (bf16_t*)(P->ws + OFF_MV);
  float* rs = (float*)(lds + 65536);
  const int tid = ltid();
  const int G_ = gridDim.x; const bool split_ = G_ > 128;
  for (int u = split_ ? (blockIdx.x < 64 ? (int)blockIdx.x : 64 + ((int)blockIdx.x - 64)) : (int)blockIdx.x; u < 64 + 768 + 1024;
       u += split_ ? (blockIdx.x < 64 ? (1 << 30) : (G_ - 64)) : G_) {
    if (u < 64) {
      const int kv = u >> 5, mt = (u >> 1) & 15, nt = u & 1;
      const bf16_t* Bt = (kv ? W + WE_CV1 : W + WE_CK1) + (size_t)j * 524288;
      auto arow = [&](int r) { int R = r < 2032 ? r : 2031; int b = R / 254, rem = R - b * 254; int c = rem >> 1, hk = rem & 1;
        return proj + (size_t)(b * SEQL + 16 * c) * LDP + 512 + kv * 128 + hk * 64; };
      auto epi = [&](int m, int n, f32x4 v, int, int) {
        if (m >= 2032) return;
        const float4 pbv = *(const float4*)(posb + (j * 2 + kv) * 256 + n);
        f32x4 o; o[0] = gelu_tanh(v[0] + pbv.x); o[1] = gelu_tanh(v[1] + pbv.y); o[2] = gelu_tanh(v[2] + pbv.z); o[3] = gelu_tanh(v[3] + pbv.w);
        st_bf16x4(hid + ((size_t)kv * 2048 + m) * 256 + n, o);
      };
      gemm128(arow, LDP, Bt, 2048, mt * 128, nt * 128, 2048, lds, epi);
      continue;
    }
    const bool isq = u < 64 + 768;
    int mt, nt;
    if (isq) { int t = u - 64; mt = t / 6; nt = t - mt * 6; } else { int t = u - 64 - 768; mt = t >> 3; nt = t & 7; }
    const int KK = isq ? 256 : 128; const int coff = isq ? 1792 : 2048;
    __syncthreads();
    {
      const int r = tid >> 1, hf = tid & 1; const int len = KK >> 1;
      const bf16_t* src = proj + (size_t)(mt * 128 + r) * LDP + coff + hf * len;
      float ss = 0.f;
      for (int i = 0; i < len; i += 8) { uint4 a = *(const uint4*)(src + i);
        float f0 = lo2f(a.x), f1 = hi2f(a.x), f2 = lo2f(a.y), f3 = hi2f(a.y), f4 = lo2f(a.z), f5 = hi2f(a.z), f6 = lo2f(a.w), f7 = hi2f(a.w);
        ss += f0 * f0 + f1 * f1 + f2 * f2 + f3 * f3 + f4 * f4 + f5 * f5 + f6 * f6 + f7 * f7; }
      ss += __shfl_xor(ss, 1);
      if (hf == 0) rs[r] = rsqrtf(ss / (float)KK + 1e-6f);
    }
    __syncthreads();
    auto arow = [&](int r) { return proj + (size_t)r * LDP + coff; };
    if (isq) {
      auto epi = [&](int m, int n, f32x4 v, int, int) -> f32x4 {
        v = v * rs[m - mt * 128];
        const int h = n / 96, c = n - h * 96;
        if (c >= 64) { const int i0 = (c - 64) >> 1; v = rope4(v, (const float2*)(P->ws + OFF_ROPE), m, i0); }
        return v * (0.10206207261596575f * LOG2E);
      };
      gemm128<true>(arow, 64, W + WE_UQ + (size_t)j * 196608, 256, mt * 128, nt * 128, 256, lds, epi, mq + nt * 128, 768, mq + nt * 128 + 64, 768);
    } else {
      auto epi = [&](int m, int, f32x4 v, int, int) -> f32x4 { return v * rs[m - mt * 128]; };
      gemm128<true>(arow, 64, W + WE_UKV + (size_t)j * 131072, 128, mt * 128, nt * 128, 128, lds, epi, mk + nt * 96, 768, mv + nt * 64, 512);
    }
  }
}
__device__ void phase_odd_b(KP P, int layer, char* lds) {
  const int j = layer >> 1;
  const bf16_t* W = (const bf16_t*)(P->ws + OFF_W);
  const bf16_t* hid = (const bf16_t*)(P->ws + OFF_HID);
  for (int u = blockIdx.x; u < 32; u += gridDim.x) {
    const int kv = u >> 4, mt = u & 15;
    bf16_t* dst = (bf16_t*)(P->ws + (kv ? OFF_VC : OFF_KC));
    const bf16_t* Bt = (kv ? W + WE_CV2 : W + WE_CK2) + (size_t)j * 32768;
    auto arow = [&](int r) { return hid + ((size_t)kv * 2048 + r) * 256; };
    auto epi = [&](int m, int n, f32x4 v, int, int) {
      if (m >= 2032 || n >= 64) return;
      const int b = m / 254, rem = m - b * 254; const int c = rem >> 1, hk = rem & 1;
      st_bf16x4(dst + ((size_t)(b * 128 + c) * 2 + hk) * 64 + n, v);
    };
    gemm128(arow, 64, Bt, 256, mt * 128, 0, 256, lds, epi);
  }
}

constexpr int LDS_KR = 16384, LDS_V = 20480, LDS_PSLC = 40960, LDS_SELM = 45056, LDS_OC = 46080;
DEV int swz_rope(int row, int c) { return row * 64 + ((c ^ ((0x1320 >> (((row >> 2) & 3) * 4)) & 3)) << 4); }

template <int DQK>
struct KVRegs { u32x4 k[DQK == 96 ? 3 : 2]; u32x4 v[2]; };

template <int DQK>
DEV void kv_load(KVRegs<DQK>& R, const bf16_t* Kb, size_t ldk, const bf16_t* Vb, size_t ldv, int key0, int tid) {
  constexpr int CPR = DQK / 8;
#pragma unroll
  for (int i = 0; i < (DQK == 96 ? 3 : 2); ++i) { const int id = tid + i * 256; const int row = id / CPR, c = id - row * CPR; R.k[i] = *(const u32x4*)(Kb + (size_t)(key0 + row) * ldk + c * 8); }
#pragma unroll
  for (int i = 0; i < 2; ++i) { const int id = tid + i * 256; const int row = id >> 3, c = id & 7; R.v[i] = *(const u32x4*)(Vb + (size_t)(key0 + row) * ldv + c * 8); }
}
template <int DQK>
DEV void kv_store(const KVRegs<DQK>& R, char* lds, int rowoff, int tid) {
  constexpr int CPR = DQK / 8;
#pragma unroll
  for (int i = 0; i < (DQK == 96 ? 3 : 2); ++i) { const int id = tid + i * 256; const int row = id / CPR, c = id - row * CPR;
    if (c < 8) *(u32x4*)(lds + swz(rowoff + row, c)) = R.k[i]; else *(u32x4*)(lds + LDS_KR + swz_rope(row, c - 8)) = R.k[i]; }
#pragma unroll
  for (int i = 0; i < 2; ++i) { const int id = tid + i * 256; const int row = id >> 3, c = id & 7; *(u32x4*)(lds + LDS_V + (rowoff + row) * 160 + c * 16) = R.v[i]; }
}
DEV bf16x8 v_frag(const char* lds, int rowbase, int dd, int lane) {
  const int g = lane >> 4, q = (lane >> 2) & 3, p = lane & 3;
  const char* a = lds + LDS_V + (rowbase + 4 * g + q) * 160 + (dd * 16 + 4 * p) * 2;
  s16x4 lo = __builtin_amdgcn_ds_read_tr16_b64_v4i16((__attribute__((address_space(3))) s16x4*)(a));
  s16x4 hi = __builtin_amdgcn_ds_read_tr16_b64_v4i16((__attribute__((address_space(3))) s16x4*)(a + 16 * 160));
  return (bf16x8){lo[0], lo[1], lo[2], lo[3], hi[0], hi[1], hi[2], hi[3]};
}
DEV bf16x8 pack_p(f32x4 a, f32x4 b) { union { uint4 u; bf16x8 v; } c; c.u = make_uint4(pk2(a[0], a[1]), pk2(a[2], a[3]), pk2(b[0], b[1]), pk2(b[2], b[3])); return c.v; }

template <int DQK, int MODE>
DEV void flash_loop(const bf16x8 (&qf)[2][DQK / 32], int qpos0, int wq_min, int wq_max,
                    const bf16_t* Kb, size_t ldk, const bf16_t* Vb, size_t ldv,
                    int kt0, int kt1, uint32_t tilemask, float slope2, uint32_t sm0, uint32_t sm1,
                    char* lds, f32x4 (&O)[2][4], float (&m)[2], float (&l)[2], int tid) {
  const int lane = tid & 63; const int fr = lane & 15, fq = lane >> 4;
  KVRegs<DQK> R;
  int kt = kt0;
  if (MODE == 2) { kt = tilemask ? __builtin_ctz(tilemask) : kt1; }
  if (kt < kt1) kv_load<DQK>(R, Kb, ldk, Vb, ldv, kt * 64, tid);
  while (kt < kt1) {
    __syncthreads();
    kv_store<DQK>(R, lds, 0, tid);
    __syncthreads();
    int nxt = kt + 1;
    if (MODE == 2) { uint32_t rem = tilemask & ~((2u << kt) - 1u); nxt = rem ? __builtin_ctz(rem) : kt1; }
    if (nxt < kt1) kv_load<DQK>(R, Kb, ldk, Vb, ldv, nxt * 64, tid);
    bool skip = (kt * 64 > wq_max);
    if (MODE == 1) skip = skip || (wq_min - (kt * 64 + 63) >= 512);
    if (!skip) {
      const bool full = (MODE == 0) ? (kt * 64 + 63 <= wq_min)
                      : (MODE == 1) ? ((kt * 64 + 63 <= wq_min) && (wq_max - kt * 64 < 512)) : false;
      bf16x8 pf[2][2];
#pragma unroll
      for (int qi = 0; qi < 2; ++qi) {
        f32x4 s[4];
#pragma unroll
        for (int ks = 0; ks < 4; ++ks) {
          s[ks] = (f32x4){0.f, 0.f, 0.f, 0.f};
#pragma unroll
          for (int kk = 0; kk < 2; ++kk) s[ks] = mfma16(*(const bf16x8*)(lds + swz(ks * 16 + fr, kk * 4 + fq)), qf[qi][kk], s[ks]);
          if (DQK == 96) s[ks] = mfma16(*(const bf16x8*)(lds + LDS_KR + swz_rope(ks * 16 + fr, fq)), qf[qi][DQK / 32 - 1], s[ks]);
        }
        const int qp = qpos0 + qi * 16;
        const uint32_t smq = qi ? sm1 : sm0;
        const int qoff = qp - (kt * 64 + fq * 4);
        const float bias0 = -slope2 * (float)qoff;
        float mx = -1e30f;
        if (full) {
#pragma unroll
          for (int ks = 0; ks < 4; ++ks)
#pragma unroll
            for (int jj = 0; jj < 4; ++jj) {
              float sc = s[ks][jj];
              if (MODE != 0) sc = sc + (bias0 + slope2 * (float)(ks * 16 + jj));
              s[ks][jj] = sc; mx = fmaxf(mx, sc);
            }
        } else {
          const bool selok = (MODE == 2) ? (((smq >> kt) & 1u) != 0u) : true;
#pragma unroll
          for (int ks = 0; ks < 4; ++ks)
#pragma unroll
            for (int jj = 0; jj < 4; ++jj) {
              const int dist = qoff - (ks * 16 + jj);
              bool valid = (dist >= 0) && selok;
              if (MODE == 1) valid = valid && (dist < 512);
              float sc = s[ks][jj];
              if (MODE != 0) sc = sc + (bias0 + slope2 * (float)(ks * 16 + jj));
              sc = valid ? sc : -INFINITY;
              s[ks][jj] = sc; mx = fmaxf(mx, sc);
            }
        }
        mx = fmaxf(mx, __shfl_xor(mx, 16)); mx = fmaxf(mx, __shfl_xor(mx, 32));
        const float mnew = fmaxf(m[qi], mx);
        const float alpha = fexp2(m[qi] - mnew);
        m[qi] = mnew;
        float ps = 0.f;
#pragma unroll
        for (int ks = 0; ks < 4; ++ks)
#pragma unroll
          for (int jj = 0; jj < 4; ++jj) { const float pv = fexp2(s[ks][jj] - mnew); s[ks][jj] = pv; ps += pv; }
        l[qi] = l[qi] * alpha + ps;
#pragma unroll
        for (int dd = 0; dd < 4; ++dd) O[qi][dd] = O[qi][dd] * alpha;
        pf[qi][0] = pack_p(s[0], s[1]); pf[qi][1] = pack_p(s[2], s[3]);
      }
#pragma unroll
      for (int dd = 0; dd < 4; ++dd)
#pragma unroll
        for (int s2 = 0; s2 < 2; ++s2) {
          const bf16x8 vf = v_frag(lds, s2 * 32, dd, lane);
          O[0][dd] = mfma16(vf, pf[0][s2], O[0][dd]);
          O[1][dd] = mfma16(vf, pf[1][s2], O[1][dd]);
        }
    }
    kt = nxt;
  }
}

__device__ void nsa_unit(KP P, int unit, char* lds) {
  int tid_ = threadIdx.x; asm volatile("" : "+v"(tid_));
  const int tid = tid_, lane = tid & 63, wid = tid >> 6;
  const int fr = lane & 15, fq = lane >> 4;
  const int tt = (unit < 512) ? 63 - (unit & 63) : (unit & 63); const int hkv = (unit >> 6) & 1, b = unit >> 7;
  const int t0 = tt * 32; const int hd = hkv * 4 + wid;
  const bf16_t* proj = (const bf16_t*)(P->ws + OFF_PROJ);
  const bf16_t* prb = proj + (size_t)b * SEQL * LDP;
  const float* gl = (const float*)(P->ws + OFF_GL) + (size_t)b * SEQL * 32;
  const float slope2 = exp2f(-(float)(hd + 1)) * LOG2E;
  float* pslc = (float*)(lds + LDS_PSLC);
  uint32_t* selm = (uint32_t*)(lds + LDS_SELM);
  bf16x8 qf[2][2];
#pragma unroll
  for (int qi = 0; qi < 2; ++qi)
#pragma unroll
    for (int kk = 0; kk < 2; ++kk) qf[qi][kk] = ld8(prb + (size_t)(t0 + qi * 16 + fr) * LDP + hd * 64 + kk * 32 + fq * 8);
  const int qpos0 = t0 + fr;
  f32x4* ocl = (f32x4*)(lds + LDS_OC) + tid;
  float contrib[2][8];
  __syncthreads();
  {
    const bf16_t* kc = (const bf16_t*)(P->ws + OFF_KC) + (size_t)b * 128 * 128 + hkv * 64;
    const bf16_t* vc = (const bf16_t*)(P->ws + OFF_VC) + (size_t)b * 128 * 128 + hkv * 64;
#pragma unroll
    for (int i = 0; i < 4; ++i) { const int id = tid + i * 256; const int row = id >> 3, c = id & 7;
      *(uint4*)(lds + swz(row, c)) = *(const uint4*)(kc + (size_t)row * 128 + c * 8);
      *(uint4*)(lds + LDS_V + row * 160 + c * 16) = *(const uint4*)(vc + (size_t)row * 128 + c * 8); }
  }
  __syncthreads();
#pragma unroll
  for (int qi = 0; qi < 2; ++qi) {
    f32x4 oc[2][4];
    f32x4 s[8];
#pragma unroll
    for (int ks = 0; ks < 8; ++ks) {
      s[ks] = (f32x4){0.f, 0.f, 0.f, 0.f};
#pragma unroll
      for (int kk = 0; kk < 2; ++kk) s[ks] = mfma16(*(const bf16x8*)(lds + swz(ks * 16 + fr, kk * 4 + fq)), qf[qi][kk], s[ks]);
    }
    const int qp = qpos0 + qi * 16;
    float mx = -1e30f;
#pragma unroll
    for (int ks = 0; ks < 8; ++ks)
#pragma unroll
      for (int jj = 0; jj < 4; ++jj) {
        const int c = ks * 16 + fq * 4 + jj; const int dist = qp - (16 * c + 31);
        const bool valid = (dist >= 0) && (c < 127);
        float sc = s[ks][jj] - slope2 * (float)dist; sc = valid ? sc : -1e30f; s[ks][jj] = sc; mx = fmaxf(mx, sc);
      }
    mx = fmaxf(mx, __shfl_xor(mx, 16)); mx = fmaxf(mx, __shfl_xor(mx, 32));
    float ps = 0.f;
#pragma unroll
    for (int ks = 0; ks < 8; ++ks)
#pragma unroll
      for (int jj = 0; jj < 4; ++jj) { const float sv = s[ks][jj]; const float pv = (sv > -1e29f) ? fexp2(sv - mx) : 0.f; s[ks][jj] = pv; ps += pv; }
    ps += __shfl_xor(ps, 16); ps += __shfl_xor(ps, 32);
    const float inv = 1.0f / fmaxf(ps, 1e-30f);
    {
      float xprev = 0.f;
#pragma unroll
      for (int ks = 0; ks < 8; ++ks) {
        s[ks] = s[ks] * inv;
        const float x1 = __shfl(s[ks][3], (lane + 48) & 63);
        contrib[qi][ks] = ((s[ks][0] + s[ks][1]) + (s[ks][2] + s[ks][3])) + (fq > 0 ? x1 : xprev);
        xprev = x1;
      }
    }
#pragma unroll
    for (int dd = 0; dd < 4; ++dd) oc[qi][dd] = (f32x4){0.f, 0.f, 0.f, 0.f};
#pragma unroll
    for (int s2 = 0; s2 < 4; ++s2) {
      const bf16x8 pfr = pack_p(s[2 * s2], s[2 * s2 + 1]);
#pragma unroll
      for (int dd = 0; dd < 4; ++dd) oc[qi][dd] = mfma16(v_frag(lds, s2 * 32, dd, lane), pfr, oc[qi][dd]);
    }
    const float g0 = sigmoidf_(gl[(size_t)(t0 + qi * 16 + fr) * 32 + hd]);
#pragma unroll
    for (int dd = 0; dd < 4; ++dd) ocl[(qi * 4 + dd) * 256] = oc[qi][dd] * g0;
  }
#pragma unroll
  for (int w = 0; w < 4; ++w) {
    if (wid == w) {
#pragma unroll
      for (int qi = 0; qi < 2; ++qi)
#pragma unroll
        for (int ks = 0; ks < 8; ++ks) {
          float* pp = pslc + (qi * 16 + fr) * 32 + ks * 4 + fq;
          if (w == 0) *pp = contrib[qi][ks]; else *pp += contrib[qi][ks];
        }
    }
    __syncthreads();
  }
  const int cur = t0 >> 6;
  {
    uint32_t mask = 0;
    if (tid < 32) {
      if (cur + 1 <= 8) mask = (2u << cur) - 1u;
      else {
        mask = 1u | (1u << cur) | (1u << (cur - 1));
        const float* pr = pslc + tid * 32;
        for (int r = 0; r < 5; ++r) {
          int best = 1; float bv = -1.0f;
          for (int jb = 1; jb <= cur - 2; ++jb) { const float v = pr[jb]; if (!((mask >> jb) & 1u) && v > bv) { bv = v; best = jb; } }
          mask |= 1u << best;
        }
      }
      selm[tid] = mask;
    }
    if (wid == 0) {
      uint32_t um = mask;
#pragma unroll
      for (int o = 32; o > 0; o >>= 1) um |= __shfl_xor(um, o);
      if (lane == 0) selm[32] = um;
    }
  }
  __syncthreads();
  const uint32_t sm0 = selm[fr], sm1 = selm[16 + fr], umask = selm[32];
  {
    f32x4 O[2][4]; float m[2] = {-1e30f, -1e30f}, l[2] = {0.f, 0.f};
#pragma unroll
    for (int qi = 0; qi < 2; ++qi)
#pragma unroll
      for (int dd = 0; dd < 4; ++dd) O[qi][dd] = (f32x4){0.f, 0.f, 0.f, 0.f};
    flash_loop<64, 2>(qf, qpos0, t0, t0 + 31, prb + 512 + 2 * 128 + hkv * 64, LDP, prb + 512 + 3 * 128 + hkv * 64, LDP,
                      0, cur + 1, umask, slope2, sm0, sm1, lds, O, m, l, tid);
#pragma unroll
    for (int qi = 0; qi < 2; ++qi) {
      float ls = l[qi]; ls += __shfl_xor(ls, 16); ls += __shfl_xor(ls, 32);
      const float g1 = sigmoidf_(gl[(size_t)(t0 + qi * 16 + fr) * 32 + 8 + hd]) / fmaxf(ls, 1e-30f);
#pragma unroll
      for (int dd = 0; dd < 4; ++dd) ocl[(qi * 4 + dd) * 256] += O[qi][dd] * g1;
    }
  }
  bf16_t* mixp = (bf16_t*)(P->ws + OFF_MIX) + (size_t)b * SEQL * DM;
  {
    f32x4 O[2][4]; float m[2] = {-1e30f, -1e30f}, l[2] = {0.f, 0.f};
#pragma unroll
    for (int qi = 0; qi < 2; ++qi)
#pragma unroll
      for (int dd = 0; dd < 4; ++dd) O[qi][dd] = (f32x4){0.f, 0.f, 0.f, 0.f};
    int k0 = (t0 - 511) >> 6; if (k0 < 0) k0 = 0;
    flash_loop<64, 1>(qf, qpos0, t0, t0 + 31, prb + 512 + 4 * 128 + hkv * 64, LDP, prb + 512 + 5 * 128 + hkv * 64, LDP,
                      k0, cur + 1, 0u, slope2, 0u, 0u, lds, O, m, l, tid);
#pragma unroll
    for (int qi = 0; qi < 2; ++qi) {
      float ls = l[qi]; ls += __shfl_xor(ls, 16); ls += __shfl_xor(ls, 32);
      const float g2 = sigmoidf_(gl[(size_t)(t0 + qi * 16 + fr) * 32 + 16 + hd]) / fmaxf(ls, 1e-30f);
      const int tok = t0 + qi * 16 + fr;
#pragma unroll
      for (int dd = 0; dd < 4; ++dd) {
        const int d = hd * 64 + dd * 16 + fq * 4;
        f32x4 gn = ld_bf16x4(prb + (size_t)tok * LDP + 1280 + d);
        f32x4 o = ocl[(qi * 4 + dd) * 256] + O[qi][dd] * g2;
#pragma unroll
        for (int i = 0; i < 4; ++i) o[i] *= siluf_(gn[i]);
        st_bf16x4(mixp + (size_t)tok * DM + d, o);
      }
    }
  }
}

__device__ void mla_unit(KP P, int unit, char* lds) {
  int tid_ = threadIdx.x; asm volatile("" : "+v"(tid_));
  const int tid = tid_, lane = tid & 63, wid = tid >> 6;
  const int fr = lane & 15, fq = lane >> 4;
  int qt; if (unit < 512) qt = 15 - (unit >> 6); else qt = (unit - 512) >> 6;
  const int bh = unit & 63; const int b = bh >> 3, hd = bh & 7;
  const int t0 = qt * 128 + wid * 32;
  const bf16_t* mq = (const bf16_t*)(P->ws + OFF_HB2) + (size_t)b * SEQL * 768 + hd * 96;
  const bf16_t* mk = (const bf16_t*)(P->ws + OFF_MK) + (size_t)b * SEQL * 768 + hd * 96;
  const bf16_t* mv = (const bf16_t*)(P->ws + OFF_MV) + (size_t)b * SEQL * 512 + hd * 64;
  bf16x8 qf[2][3];
#pragma unroll
  for (int qi = 0; qi < 2; ++qi)
#pragma unroll
    for (int kk = 0; kk < 3; ++kk) qf[qi][kk] = ld8(mq + (size_t)(t0 + qi * 16 + fr) * 768 + kk * 32 + fq * 8);
  f32x4 O[2][4]; float m[2] = {-1e30f, -1e30f}, l[2] = {0.f, 0.f};
#pragma unroll
  for (int qi = 0; qi < 2; ++qi)
#pragma unroll
    for (int dd = 0; dd < 4; ++dd) O[qi][dd] = (f32x4){0.f, 0.f, 0.f, 0.f};
  flash_loop<96, 0>(qf, t0 + fr, t0, t0 + 31, mk, 768, mv, 512, 0, qt * 2 + 2, 0u, 0.f, 0u, 0u, lds, O, m, l, tid);
  const bf16_t* prb = (const bf16_t*)(P->ws + OFF_PROJ) + (size_t)b * SEQL * LDP;
  bf16_t* mix = (bf16_t*)(P->ws + OFF_MIX) + (size_t)b * SEQL * DM;
#pragma unroll
  for (int qi = 0; qi < 2; ++qi) {
    float ls = l[qi]; ls += __shfl_xor(ls, 16); ls += __shfl_xor(ls, 32);
    const float inv = 1.0f / fmaxf(ls, 1e-30f);
#pragma unroll
    for (int dd = 0; dd < 4; ++dd) {
      const int tok = t0 + qi * 16 + fr; const int d = hd * 64 + dd * 16 + fq * 4;
      f32x4 gm = ld_bf16x4(prb + (size_t)tok * LDP + 2208 + d);
      f32x4 o = O[qi][dd] * inv;
#pragma unroll
      for (int i = 0; i < 4; ++i) o[i] *= siluf_(gm[i]);
      st_bf16x4(mix + (size_t)tok * DM + 512 + d, o);
    }
  }
}
__device__ void phase_odd_c(KP P, int layer, char* lds) {
  for (int u = blockIdx.x; u < 1024 + 1024; u += gridDim.x) {
#ifndef ATT_ONLY
#define ATT_ONLY 3
#endif
    if (u < 1024) { if (ATT_ONLY & 1) nsa_unit(P, remap_nsa(u), lds); } else { if (ATT_ONLY & 2) mla_unit(P, remap_mla(u - 1024), lds); }
  }
}

#ifndef DBG_LAST
#define DBG_LAST -1
#endif
#ifndef DBG_WHICH
#define DBG_WHICH 0
#endif
__device__ void dbg_dump(KP P) {
  const int tid = ltid();
  const bf16_t* ya = (const bf16_t*)(P->ws + OFF_HB2);
  const bf16_t* hc = ya + (size_t)T_TOK * 512;
  const bf16_t* mix = (const bf16_t*)(P->ws + OFF_MIX);
  const bf16_t* proj = (const bf16_t*)(P->ws + OFF_PROJ);
  const float* y = (const float*)(P->ws + OFF_PROJ);
  for (size_t i = (size_t)blockIdx.x * NTHREADS + tid; i < (size_t)T_TOK * DM; i += (size_t)gridDim.x * NTHREADS) {
    const size_t m = i >> 10; const int n = (int)(i & 1023);
    float v;
    if (DBG_WHICH == 0) v = bf2f(proj[m * LDP + n]);
    else if (DBG_WHICH == 1) v = bf2f(proj[m * LDP + 1024 + n]);
    else if (DBG_WHICH == 2) v = n < 512 ? bf2f(hc[m * 512 + n]) : ((const float*)(P->ws + OFF_MK))[(m * 512 + (n - 512)) & 1048575];
    else if (DBG_WHICH == 3) v = n < 512 ? bf2f(ya[m * 512 + n]) : bf2f(mix[m * DM + n]);
    else if (DBG_WHICH == 4) v = bf2f(mix[m * DM + n]);
    else if (DBG_WHICH == 5) v = y[m * DM + n];
    else if (DBG_WHICH == 7) v = bf2f(ya[m * DM + n]);
    else if (DBG_WHICH == 8) {
      const bf16_t* W = (const bf16_t*)(P->ws + OFF_W); const bf16_t* pb = (const bf16_t*)(P->ws + OFF_PB);
      if (n < 256) v = bf2f(pb[m * 256 + n]);
      else if (n < 512) v = bf2f(W[WE_PPROJ + ((m * 256 + (n - 256)) & 262143)]);
      else v = bf2f(W[WE_GATE + ((m * 512 + (n - 512)) & 1048575)]);
    }
    else v = bf2f(proj[m * LDP + 1536 + n]);
    P->out[i] = v;
  }
}
#define XB_TMO      128
#define XB_XCNT(j)  (256  + 64 * (j))
#define XB_XSUB(j)  (1280 + 64 * (j))
#define XB_XGEN(j)  (2304 + 64 * (j))
#define XB_TOP      3328
#define XB_TOPGEN   3392
#define XCD_BAR_WORDS 3456
#define XB_SPIN_CAP (1u << 20)
DEV unsigned xb_ld(unsigned* p)              { return __hip_atomic_load(p, __ATOMIC_RELAXED, __HIP_MEMORY_SCOPE_AGENT); }
DEV unsigned xb_add(unsigned* p, unsigned v) { return __hip_atomic_fetch_add(p, v, __ATOMIC_RELAXED, __HIP_MEMORY_SCOPE_AGENT); }
DEV unsigned xb_xcc_id() { return (unsigned)__builtin_amdgcn_s_getreg((3 << 11) | 20) & 0xFu; }
#define XB_SPIN(cond, bar) do { unsigned _sp = 0; while (cond) { __builtin_amdgcn_s_sleep(1); \
    if ((++_sp & 255u) == 0u) { if (xb_ld(&(bar)[XB_TMO])) break; if (_sp > XB_SPIN_CAP) { atomicAdd(&(bar)[XB_TMO], 1u); break; } } } } while (0)
struct XcdBarrier { unsigned* bar; unsigned x; volatile LAS3 unsigned* st; };
DEV XcdBarrier xcd_barrier_post(unsigned* bar, volatile LAS3 unsigned* st) {
  XcdBarrier b; b.bar = bar; b.x = xb_xcc_id(); b.st = st;
  if (threadIdx.x == 0) (void)xb_add(&bar[XB_XCNT(b.x)], 1u);
  return b;
}
DEV void xcd_barrier_complete(unsigned* bar, unsigned x, unsigned& nloc, unsigned& nx) {
  const unsigned G = gridDim.x;
  unsigned sum, cnt, mine, sp = 0u;
  for (;;) {
    sum = 0u; cnt = 0u; mine = 0u;
#pragma unroll
    for (unsigned j = 0; j < 16; ++j) { const unsigned c = xb_ld(&bar[XB_XCNT(j)]); sum += c; cnt += (c > 0u) ? 1u : 0u; mine = (j == x) ? c : mine; }
    if (sum == G) break;
    __builtin_amdgcn_s_sleep(1);
    if ((++sp & 255u) == 0u) { if (xb_ld(&bar[XB_TMO])) break; if (sp > XB_SPIN_CAP) { atomicAdd(&bar[XB_TMO], 1u); break; } }
  }
  nloc = mine > 0u ? mine : 1u; nx = cnt > 0u ? cnt : 1u;
}
DEV void xcd_barrier(const XcdBarrier& b) {
  asm volatile("s_waitcnt vmcnt(0)" ::: "memory");
  __syncthreads();
  if (threadIdx.x == 0) {
    unsigned* bar = b.bar;
    __builtin_amdgcn_s_waitcnt(0);
    unsigned nloc = b.st[0], nx = b.st[1];
    if (nloc == 0u) { xcd_barrier_complete(bar, b.x, nloc, nx); b.st[0] = nloc; b.st[1] = nx; }
    const unsigned old = xb_add(&bar[XB_XSUB(b.x)], 1u);
    const unsigned gen = old / nloc;
    if (old + 1u == (gen + 1u) * nloc) {
      __builtin_amdgcn_fence(__ATOMIC_RELEASE, "agent");
      asm volatile("s_waitcnt vmcnt(0)" ::: "memory");
      const unsigned og = xb_add(&bar[XB_TOP], 1u);
      const unsigned tg = og / nx;
      if (og + 1u == (tg + 1u) * nx) xb_add(&bar[XB_TOPGEN], 1u);
      else XB_SPIN(xb_ld(&bar[XB_TOPGEN]) == tg, bar);
      __builtin_amdgcn_fence(__ATOMIC_ACQUIRE, "agent");
      xb_add(&bar[XB_XGEN(b.x)], 1u);
      asm volatile("s_waitcnt vmcnt(0)" ::: "memory");
    } else {
      XB_SPIN(xb_ld(&bar[XB_XGEN(b.x)]) == gen, bar);
      __builtin_amdgcn_fence(__ATOMIC_ACQUIRE, "agent");
      asm volatile("s_waitcnt vmcnt(0)" ::: "memory");
    }
  }
  __syncthreads();
}
#ifndef NLAY
#define NLAY 4
#endif
constexpr int N_PHASES = 1 + NLAY * 7;

__global__ void __launch_bounds__(NTHREADS, 2) fwd_kernel(Params Pin) {
  __shared__ __attribute__((aligned(16))) char lds_[LDS_BYTES];
  KP P0 = (KP)__builtin_amdgcn_kernarg_segment_ptr();
  const int ph_lo = P0->phase_lo, ph_hi = P0->phase_hi, coop = P0->coop;
  __shared__ uint4 xb_words;
  if (threadIdx.x == 0) xb_words = make_uint4(0u, 0u, 0u, 0u);
  __syncthreads();
  XcdBarrier xb = xcd_barrier_post((unsigned*)(P0->ws + OFF_BAR), (volatile LAS3 unsigned*)&xb_words);
  for (int ph = ph_lo; ph <= ph_hi; ++ph) {
    KP P = P0; asm volatile("" : "+s"(P));
    int lds_off = 0; asm volatile("" : "+s"(lds_off));
    char* lds = lds_ + lds_off;
#ifndef PHM
#define PHM 0xffff
#endif
#ifndef REP_PRO
#define REP_PRO 1
#endif
#ifndef REP_PLE
#define REP_PLE 1
#endif
    if (ph == 0) {
#pragma unroll 1
      for (int r_ = 0; r_ < REP_PRO; ++r_) phase_prologue(P, lds); }
    else {
      const int layer = (ph - 1) / 7, sub = (ph - 1) % 7;
      const bool odd = layer & 1;
      switch (sub) {
#ifndef REP_WIN
#define REP_WIN 1
#endif
#ifndef REP_OUT
#define REP_OUT 1
#endif
        case 0: if (PHM & 2) {
#pragma unroll 1
          for (int r_ = 0; r_ < REP_WIN; ++r_) phase_win(P, layer, lds); } break;
#ifndef REP_OA
#define REP_OA 1
#endif
#ifndef REP_OC
#define REP_OC 1
#endif
#ifndef REP_EA
#define REP_EA 1
#endif
#ifndef REP_EB
#define REP_EB 1
#endif
#ifndef REP_EC
#define REP_EC 1
#endif
#ifndef REP_RP
#define REP_RP 1
#endif
        case 1: if (odd) {
#pragma unroll 1
            for (int r_ = 0; r_ < REP_OA; ++r_) phase_odd_a(P, layer, lds);
          } else {
#pragma unroll 1
            for (int r_ = 0; r_ < REP_EA; ++r_) phase_even_a(P, layer, lds);
          } break;
        case 2: if (odd) { phase_odd_b(P, layer, lds); } else {
#pragma unroll 1
            for (int r_ = 0; r_ < REP_EB; ++r_) phase_even_b(P, layer, lds);
          } break;
        case 3: if (odd) {
#pragma unroll 1
            for (int r_ = 0; r_ < REP_OC; ++r_) phase_odd_c(P, layer, lds);
          } else {
#pragma unroll 1
            for (int r_ = 0; r_ < REP_EC; ++r_) phase_even_c(P, layer, lds);
          } break;
        case 4: if (PHM & 256) {
#pragma unroll 1
          for (int r_ = 0; r_ < REP_OUT; ++r_) phase_out(P, layer, lds); } break;
        case 5: {
#pragma unroll 1
          for (int r_ = 0; r_ < ((layer == 0) ? REP_RP : 1); ++r_) phase_rowpass(P, layer); } break;
        default: {
#pragma unroll 1
          for (int r_ = 0; r_ < REP_PLE; ++r_) phase_ple(P, layer, lds); } break;
      }
    }
#ifndef REP_SYNC
#define REP_SYNC 1
#endif
    if (ph < ph_hi && coop) {
      if (P0->pad0 != 0) cg::this_grid().sync();
      xcd_barrier(xb);
    }
  }
  if (DBG_LAST >= 0) { cg::this_grid().sync(); dbg_dump(P0); }
}

#ifndef USE_COOP
#define USE_COOP 1
#endif

extern "C" void kernel_launch(void* const* d_in, const int* in_sizes, int n_in, void* d_out, int out_size, void* d_ws, size_t ws_size, hipStream_t stream) {
  (void)in_sizes; (void)n_in; (void)out_size;
  if (ws_size < WS_NEED) { fprintf(stderr, "workspace too small: %zu < %zu\n", ws_size, (size_t)WS_NEED); return; }
  Params P{};
  int a = 0;
  P.x = (const float*)d_in[a++]; P.p = (const float*)d_in[a++]; P.pos = (const int*)d_in[a++];
  P.pre_norm = (const float*)d_in[a++]; P.post_norm = (const float*)d_in[a++]; P.ple_gate = (const float*)d_in[a++]; P.ple_proj = (const float*)d_in[a++];
  P.ev_w_in = (const float*)d_in[a++]; P.lam_re = (const float*)d_in[a++]; P.lam_im = (const float*)d_in[a++]; P.b_re = (const float*)d_in[a++]; P.b_im = (const float*)d_in[a++];
  P.c_re = (const float*)d_in[a++]; P.c_im = (const float*)d_in[a++]; P.s5_d = (const float*)d_in[a++]; P.log_step = (const float*)d_in[a++]; P.w_glu = (const float*)d_in[a++]; P.b_glu = (const float*)d_in[a++];
  P.w_dw = (const float*)d_in[a++]; P.b_dw = (const float*)d_in[a++]; P.ln_g = (const float*)d_in[a++]; P.ln_b = (const float*)d_in[a++]; P.w_pw = (const float*)d_in[a++]; P.ev_w_out = (const float*)d_in[a++];
  P.od_w_in = (const float*)d_in[a++]; P.pos_k = (const float*)d_in[a++]; P.pos_v = (const float*)d_in[a++]; P.ck_w1 = (const float*)d_in[a++]; P.ck_w2 = (const float*)d_in[a++]; P.cv_w1 = (const float*)d_in[a++]; P.cv_w2 = (const float*)d_in[a++];
  P.q_norm = (const float*)d_in[a++]; P.kv_norm = (const float*)d_in[a++]; P.w_uq = (const float*)d_in[a++]; P.w_ukv = (const float*)d_in[a++]; P.od_w_out = (const float*)d_in[a++];
  P.out = (float*)d_out; P.ws = (char*)d_ws;
  static int grid_blocks = 0;
  if (!grid_blocks) {
    int dev = 0, cus = 0, per_cu = 0;
    (void)hipGetDevice(&dev);
    (void)hipDeviceGetAttribute(&cus, hipDeviceAttributeMultiprocessorCount, dev);
    (void)hipOccupancyMaxActiveBlocksPerMultiprocessor(&per_cu, fwd_kernel, NTHREADS, 0);
    if (per_cu > 2) per_cu = 2;
    if (per_cu < 1) per_cu = 1;
    grid_blocks = cus * per_cu;
  }
#if USE_COOP
  (void)hipMemsetAsync((char*)d_ws + OFF_BAR, 0, 16384, stream);
  P.phase_lo = 0; P.phase_hi = (DBG_LAST >= 0) ? DBG_LAST : N_PHASES - 1; P.coop = 1;
  void* args[] = {&P};
  hipError_t e = hipLaunchCooperativeKernel((void*)fwd_kernel, dim3(grid_blocks), dim3(NTHREADS), args, 0, stream);
  if (e != hipSuccess) fprintf(stderr, "cooperative launch failed: %s (grid %d)\n", hipGetErrorString(e), grid_blocks);
#else
  for (int ph = 0; ph < N_PHASES; ++ph) {
    P.phase_lo = ph; P.phase_hi = ph; P.coop = 0;
    fwd_kernel<<<grid_blocks, NTHREADS, 0, stream>>>(P);
  }
#endif
}
```

```cpp
#include <hip/hip_runtime.h>
#include <hip/hip_cooperative_groups.h>
#include <stdint.h>
#include <cstdio>
namespace cg = cooperative_groups;

typedef unsigned short bf16_t;
typedef short bf16x8 __attribute__((ext_vector_type(8)));
typedef short s16x4 __attribute__((ext_vector_type(4)));
typedef float f32x4 __attribute__((ext_vector_type(4)));
typedef unsigned int u32x4 __attribute__((ext_vector_type(4)));

#define DEV __device__ __forceinline__
#define LAS3 __attribute__((address_space(3)))

constexpr int T_TOK = 16384, SEQL = 2048, DM = 1024, LDP = 2816;
constexpr int NTHREADS = 256;
constexpr int LDS_BYTES = 80896;
constexpr float LOG2E = 1.4426950408889634f;

constexpr size_t MBY = 1u << 20;
constexpr size_t OFF_W = 0;
constexpr size_t OFF_PROJ = 48 * MBY;
constexpr size_t OFF_MIX = OFF_PROJ + 88 * MBY;
constexpr size_t OFF_HB2 = OFF_MIX + 32 * MBY;
constexpr size_t OFF_PB = OFF_HB2 + 32 * MBY;
constexpr size_t OFF_MK = OFF_PB + 8 * MBY;
constexpr size_t OFF_MV = OFF_MK + 24 * MBY;
constexpr size_t OFF_SMALL = OFF_MV + 16 * MBY;
constexpr size_t OFF_GL = OFF_SMALL;
constexpr size_t OFF_HID = OFF_GL + 2 * MBY;
constexpr size_t OFF_KC = OFF_HID + 2 * MBY;
constexpr size_t OFF_VC = OFF_KC + 262144;
constexpr size_t OFF_RSPRE = OFF_VC + 262144;
constexpr size_t OFF_RSPOST = OFF_RSPRE + 65536;
constexpr size_t OFF_S5A = OFF_RSPOST + 65536;
constexpr size_t OFF_BBR = OFF_S5A + 65536;
constexpr size_t OFF_BBI = OFF_BBR + 262144;
constexpr size_t OFF_CM = OFF_BBI + 262144;
constexpr size_t OFF_POSB = OFF_CM + 262144;
constexpr size_t OFF_ROPE = OFF_POSB + 4096;
constexpr size_t OFF_BAR = OFF_ROPE + 2 * MBY;
constexpr size_t WS_NEED = OFF_BAR + 16384;

constexpr size_t WE_GATE = 0;
constexpr size_t WE_PPROJ = WE_GATE + 4 * 1048576;
constexpr size_t WE_EVIN = WE_PPROJ + 4 * 262144;
constexpr size_t WE_GLU = WE_EVIN + 2 * 2560 * 1024;
constexpr size_t WE_PW = WE_GLU + 2 * 262144;
constexpr size_t WE_EVOUT = WE_PW + 2 * 262144;
constexpr size_t WE_ODIN = WE_EVOUT + 2 * 1048576;
constexpr size_t WE_CK1 = WE_ODIN + 2 * 2816 * 1024;
constexpr size_t WE_CV1 = WE_CK1 + 2 * 524288;
constexpr size_t WE_CK2 = WE_CV1 + 2 * 524288;
constexpr size_t WE_CV2 = WE_CK2 + 2 * 32768;
constexpr size_t WE_UQ = WE_CV2 + 2 * 32768;
constexpr size_t WE_UKV = WE_UQ + 2 * 196608;
constexpr size_t WE_ODOUT = WE_UKV + 2 * 131072;
constexpr size_t WE_END = WE_ODOUT + 2 * 1048576;
static_assert(WE_END * 2 <= 48 * MBY, "weights overflow");

struct Params {
  const float *x, *p; const int* pos;
  const float *pre_norm, *post_norm, *ple_gate, *ple_proj;
  const float *ev_w_in, *lam_re, *lam_im, *b_re, *b_im, *c_re, *c_im, *s5_d, *log_step, *w_glu, *b_glu;
  const float *w_dw, *b_dw, *ln_g, *ln_b, *w_pw, *ev_w_out;
  const float *od_w_in, *pos_k, *pos_v, *ck_w1, *ck_w2, *cv_w1, *cv_w2, *q_norm, *kv_norm, *w_uq, *w_ukv, *od_w_out;
  float* out; char* ws;
  int phase_lo, phase_hi, coop, pad0;
};

typedef const __attribute__((address_space(4))) Params* KP;
DEV int ltid() { int t = threadIdx.x; asm volatile("" : "+v"(t)); return t; }
DEV float bf2f(bf16_t b) { return __uint_as_float(((uint32_t)b) << 16); }
typedef float f32x2_ __attribute__((ext_vector_type(2)));
typedef __bf16 bf16x2_ __attribute__((ext_vector_type(2)));
DEV uint32_t pk2(float lo, float hi) { f32x2_ v = {lo, hi}; bf16x2_ b = __builtin_convertvector(v, bf16x2_); return __builtin_bit_cast(uint32_t, b); }
DEV bf16_t f2bf(float f) { return (bf16_t)(pk2(f, 0.f) & 0xffff); }
DEV float lo2f(uint32_t u) { return __uint_as_float(u << 16); }
DEV float hi2f(uint32_t u) { return __uint_as_float(u & 0xffff0000u); }
DEV float fexp2(float x) { return __builtin_amdgcn_exp2f(x); }
DEV float frcp(float x) { return __builtin_amdgcn_rcpf(x); }
DEV float sigmoidf_(float x) { return frcp(1.f + fexp2(-x * LOG2E)); }
DEV float siluf_(float x) { return x * sigmoidf_(x); }
DEV float gelu_tanh(float x) { float u = 1.5957691216057308f * (x + 0.044715f * x * x * x); return x * sigmoidf_(u); }
DEV f32x4 mfma16(bf16x8 a, bf16x8 b, f32x4 c) { return __builtin_amdgcn_mfma_f32_16x16x32_bf16(a, b, c, 0, 0, 0); }
DEV bf16x8 ld8(const bf16_t* p) { return *reinterpret_cast<const bf16x8*>(p); }
DEV bf16x8 as_bf16x8(uint4 v) { union { uint4 u; bf16x8 b; } c; c.u = v; return c.b; }

DEV void fsincos_q(float x, float xe, float& s, float& c) {
  const float k = rintf(x * 0.63661977236758134f);
  float r = fmaf(-k, 1.5703125f, x);
  r = fmaf(-k, 4.837512969970703125e-4f, r);
  r = fmaf(-k, 7.54978995489188216e-8f, r);
  r += xe;
  const int q = ((int)k) & 3;
  const float r2 = r * r;
  const float sp = fmaf(r * r2, fmaf(r2, fmaf(r2, fmaf(r2, 2.7557319e-6f, -1.98412698e-4f), 8.33333333e-3f), -1.66666667e-1f), r);
  const float cp = fmaf(r2, fmaf(r2, fmaf(r2, fmaf(r2, fmaf(r2, -2.75573192e-7f, 2.48015873e-5f), -1.38888889e-3f), 4.16666667e-2f), -0.5f), 1.0f);
  if (q == 0) { s = sp; c = cp; } else if (q == 1) { s = cp; c = -sp; } else if (q == 2) { s = -sp; c = -cp; } else { s = -cp; c = sp; }
}
DEV float rope_freq(int i) {
  int r = i & 3, q = i >> 2;
  float f = r == 0 ? 1.0f : (r == 1 ? 0.5623413251903491f : (r == 2 ? 0.31622776601683794f : 0.1778279410038923f));
  float s = q == 0 ? 1.0f : (q == 1 ? 0.1f : (q == 2 ? 0.01f : 0.001f));
  return f * s;
}
DEV f32x4 rope4(f32x4 v, const float2* tab, int m, int i0) {
  const float4 cs = *(const float4*)(tab + (size_t)m * 16 + i0);
  f32x4 o;
  o[0] = v[0] * cs.x - v[1] * cs.y; o[1] = v[0] * cs.y + v[1] * cs.x;
  o[2] = v[2] * cs.z - v[3] * cs.w; o[3] = v[2] * cs.w + v[3] * cs.z;
  return o;
}

DEV int swz(int row, int c) { return row * 128 + ((c ^ ((row >> 1) & 7)) << 4); }

DEV int swz32(int row, int c) { return row * 64 + ((c ^ ((0x1320 >> (((row >> 2) & 3) * 4)) & 3)) << 4); }
template <bool STAGED = false, typename AROW, typename EPI>
DEV void gemm128(AROW arow, int a_kstep, const bf16_t* __restrict__ Bt, int ldb, int m0, int n0, int K, char* lds, EPI epi,
                 bf16_t* dst0 = nullptr, int ld0 = 0, bf16_t* dst1 = nullptr, int ld1 = 0) {
  int tid_ = threadIdx.x; asm volatile("" : "+v"(tid_));
  const int tid = tid_, lane = tid & 63, wid = tid >> 6;
  const int wr = wid >> 1, wc = wid & 1;
  const int lr = tid >> 2, lcs = (tid & 3) ^ ((0x1320 >> (((tid >> 4) & 3) * 4)) & 3);
  const bf16_t* ap[2]; const bf16_t* bp[2];
#pragma unroll
  for (int i = 0; i < 2; ++i) { ap[i] = arow(m0 + lr + 64 * i) + lcs * 8; bp[i] = Bt + (size_t)(n0 + lr + 64 * i) * ldb + lcs * 8; }
  f32x4 acc[4][4];
#pragma unroll
  for (int i = 0; i < 4; ++i)
#pragma unroll
    for (int j = 0; j < 4; ++j) acc[i][j] = (f32x4){0.f, 0.f, 0.f, 0.f};
  const int nk = K >> 5;
  const int fr = lane & 15, fq = lane >> 4;
  auto issue = [&](int kt) {
    char* buf = lds + (kt & 3) * 16384 + tid * 16;
    const size_t ka = (size_t)(kt >> 1) * a_kstep + (kt & 1) * 32, kb = (size_t)kt * 32;
#pragma unroll
    for (int i = 0; i < 2; ++i) {
      __builtin_amdgcn_global_load_lds((const unsigned*)(ap[i] + ka), (unsigned*)(buf + i * 4096), 16, 0, 0);
      __builtin_amdgcn_global_load_lds((const unsigned*)(bp[i] + kb), (unsigned*)(buf + 8192 + i * 4096), 16, 0, 0);
    }
  };
  const uint32_t lds32 = (uint32_t)(size_t)(LAS3 char*)lds;
  const uint32_t aoff = swz32(wr * 64 + fr, fq), boff = 8192 + swz32(wc * 64 + fr, fq);
  auto issue1 = [&](int kt, int piece) {
    char* buf = lds + (kt & 3) * 16384 + tid * 16;
    if (piece < 2) __builtin_amdgcn_global_load_lds((const unsigned*)(ap[piece] + (size_t)(kt >> 1) * a_kstep + (kt & 1) * 32), (unsigned*)(buf + piece * 4096), 16, 0, 0);
    else __builtin_amdgcn_global_load_lds((const unsigned*)(bp[piece - 2] + (size_t)kt * 32), (unsigned*)(buf + 8192 + (piece - 2) * 4096), 16, 0, 0);
  };
  auto wait_vm = [&](int n) {
    if (n >= 3) asm volatile("s_waitcnt vmcnt(12)" ::: "memory");
    else if (n == 2) asm volatile("s_waitcnt vmcnt(8)" ::: "memory");
    else if (n == 1) asm volatile("s_waitcnt vmcnt(4)" ::: "memory");
    else asm volatile("s_waitcnt vmcnt(0)" ::: "memory");
  };
#define GEMM_RD(FA, FB, KT) do { const uint32_t aaddr_ = lds32 + ((KT) & 3) * 16384 + aoff, baddr_ = lds32 + ((KT) & 3) * 16384 + boff; \
    asm volatile("ds_read_b128 %0, %1" : "=v"(FA[0]) : "v"(aaddr_)); \
    asm volatile("ds_read_b128 %0, %1 offset:1024" : "=v"(FA[1]) : "v"(aaddr_)); \
    asm volatile("ds_read_b128 %0, %1 offset:2048" : "=v"(FA[2]) : "v"(aaddr_)); \
    asm volatile("ds_read_b128 %0, %1 offset:3072" : "=v"(FA[3]) : "v"(aaddr_)); \
    asm volatile("ds_read_b128 %0, %1" : "=v"(FB[0]) : "v"(baddr_)); \
    asm volatile("ds_read_b128 %0, %1 offset:1024" : "=v"(FB[1]) : "v"(baddr_)); \
    asm volatile("ds_read_b128 %0, %1 offset:2048" : "=v"(FB[2]) : "v"(baddr_)); \
    asm volatile("ds_read_b128 %0, %1 offset:3072" : "=v"(FB[3]) : "v"(baddr_)); } while (0)
#define GEMM_LGKM0(FA, FB) asm volatile("s_waitcnt lgkmcnt(0)" : "+v"(FA[0]), "+v"(FA[1]), "+v"(FA[2]), "+v"(FA[3]), "+v"(FB[0]), "+v"(FB[1]), "+v"(FB[2]), "+v"(FB[3]))
#define GEMM_STEP(KT, CA, CB, NA, NB) do { \
    if ((KT) + 1 < nk) { \
      int y_ = nk - (KT) - 2; wait_vm(y_ > 2 ? 2 : y_); \
      __builtin_amdgcn_s_barrier(); \
      GEMM_RD(NA, NB, (KT) + 1); \
    } \
    const bool doiss_ = (KT) + 4 < nk; \
    _Pragma("unroll") for (int mi = 0; mi < 4; ++mi) { \
      _Pragma("unroll") for (int ni = 0; ni < 4; ++ni) acc[mi][ni] = mfma16(CB[ni], CA[mi], acc[mi][ni]); \
      if (doiss_) issue1((KT) + 4, mi); \
      __builtin_amdgcn_sched_barrier(0); \
    } \
    if ((KT) + 1 < nk) GEMM_LGKM0(NA, NB); } while (0)
  asm volatile("s_waitcnt vmcnt(0)" ::: "memory");
  __syncthreads();
  issue(0);
  if (nk > 1) issue(1);
  if (nk > 2) issue(2);
  if (nk > 3) issue(3);
  bf16x8 fa0[4], fb0[4], fa1[4], fb1[4];
  wait_vm(nk - 1 > 3 ? 3 : nk - 1);
  __builtin_amdgcn_s_barrier();
  GEMM_RD(fa0, fb0, 0);
  GEMM_LGKM0(fa0, fb0);
  for (int kt = 0; kt < nk; kt += 2) {
    GEMM_STEP(kt, fa0, fb0, fa1, fb1);
    if (kt + 1 < nk) GEMM_STEP(kt + 1, fa1, fb1, fa0, fb0);
  }
  __syncthreads();
  if constexpr (!STAGED) {
#pragma unroll
    for (int mi = 0; mi < 4; ++mi)
#pragma unroll
      for (int ni = 0; ni < 4; ++ni) epi(m0 + wr * 64 + mi * 16 + fr, n0 + wc * 64 + ni * 16 + fq * 4, acc[mi][ni], mi, ni);
  } else {
    char* wb = lds + wid * 9216;
#pragma unroll
    for (int mi = 0; mi < 4; ++mi)
#pragma unroll
      for (int ni = 0; ni < 4; ++ni) {
        const f32x4 v = epi(m0 + wr * 64 + mi * 16 + fr, n0 + wc * 64 + ni * 16 + fq * 4, acc[mi][ni], mi, ni);
        uint2 w; w.x = pk2(v[0], v[1]); w.y = pk2(v[2], v[3]);
        *(uint2*)(wb + (mi * 16 + fr) * 144 + (ni * 16 + fq * 4) * 2) = w;
      }
    __builtin_amdgcn_wave_barrier();
    asm volatile("s_waitcnt lgkmcnt(0)" ::: "memory");
    const int rr = lane >> 3, ch = lane & 7;
    bf16_t* db = wc ? dst1 : dst0; const int ldd = wc ? ld1 : ld0;
    bf16_t* dp = db + (size_t)(m0 + wr * 64 + rr) * ldd + ch * 8;
#pragma unroll
    for (int it = 0; it < 8; ++it) {
      const u32x4 v = *(const u32x4*)(wb + (it * 8 + rr) * 144 + ch * 16);
      *(u32x4*)(dp + (size_t)it * 8 * ldd) = v;
    }
  }
}

template <bool STAGED, typename AROW, typename EPI>
DEV void gemm256(AROW arow, int a_kstep, const bf16_t* __restrict__ Bt, int ldb, int m0, int n0, int K, char* lds, EPI epi, bf16_t* dst = nullptr, int ldd = 0) {
  int tid_ = threadIdx.x; asm volatile("" : "+v"(tid_));
  const int tid = tid_, lane = tid & 63, wid = tid >> 6;
  const int wr = wid >> 1, wc = wid & 1;
  const int lr = tid >> 2, lcs = (tid & 3) ^ ((0x1320 >> (((tid >> 4) & 3) * 4)) & 3);
  const bf16_t* ap[4]; const bf16_t* bp[2];
#pragma unroll
  for (int i = 0; i < 4; ++i) ap[i] = arow(m0 + lr + 64 * i) + lcs * 8;
#pragma unroll
  for (int i = 0; i < 2; ++i) bp[i] = Bt + (size_t)(n0 + lr + 64 * i) * ldb + lcs * 8;
  f32x4 acc[8][4];
#pragma unroll
  for (int i = 0; i < 8; ++i)
#pragma unroll
    for (int j = 0; j < 4; ++j) acc[i][j] = (f32x4){0.f, 0.f, 0.f, 0.f};
  const int nk = K >> 5;
  const int fr = lane & 15, fq = lane >> 4;
  const uint32_t lds32 = (uint32_t)(size_t)(LAS3 char*)lds;
  const uint32_t aoff = swz32(wr * 128 + fr, fq), boff = 16384 + swz32(wc * 64 + fr, fq);
  auto issue1 = [&](int kt, int slot, int piece) {
    char* buf = lds + slot * 24576 + tid * 16;
    if (piece < 4) __builtin_amdgcn_global_load_lds((const unsigned*)(ap[piece] + (size_t)(kt >> 1) * a_kstep + (kt & 1) * 32), (unsigned*)(buf + piece * 4096), 16, 0, 0);
    else __builtin_amdgcn_global_load_lds((const unsigned*)(bp[piece - 4] + (size_t)kt * 32), (unsigned*)(buf + 16384 + (piece - 4) * 4096), 16, 0, 0);
  };
  asm volatile("s_waitcnt vmcnt(0)" ::: "memory");
  __syncthreads();
#pragma unroll
  for (int p = 0; p < 6; ++p) issue1(0, 0, p);
  if (nk > 1) {
#pragma unroll
    for (int p = 0; p < 6; ++p) issue1(1, 1, p);
  }
  int sc = 0;
  for (int kt = 0; kt < nk; ++kt) {
    if (kt + 1 < nk) asm volatile("s_waitcnt vmcnt(6)" ::: "memory"); else asm volatile("s_waitcnt vmcnt(0)" ::: "memory");
    __builtin_amdgcn_s_barrier();
    const uint32_t aaddr = lds32 + sc * 24576 + aoff, baddr = lds32 + sc * 24576 + boff;
    bf16x8 fa[8], fb[4];
    asm volatile("ds_read_b128 %0, %1" : "=v"(fa[0]) : "v"(aaddr));
    asm volatile("ds_read_b128 %0, %1 offset:1024" : "=v"(fa[1]) : "v"(aaddr));
    asm volatile("ds_read_b128 %0, %1 offset:2048" : "=v"(fa[2]) : "v"(aaddr));
    asm volatile("ds_read_b128 %0, %1 offset:3072" : "=v"(fa[3]) : "v"(aaddr));
    asm volatile("ds_read_b128 %0, %1 offset:4096" : "=v"(fa[4]) : "v"(aaddr));
    asm volatile("ds_read_b128 %0, %1 offset:5120" : "=v"(fa[5]) : "v"(aaddr));
    asm volatile("ds_read_b128 %0, %1 offset:6144" : "=v"(fa[6]) : "v"(aaddr));
    asm volatile("ds_read_b128 %0, %1 offset:7168" : "=v"(fa[7]) : "v"(aaddr));
    asm volatile("ds_read_b128 %0, %1" : "=v"(fb[0]) : "v"(baddr));
    asm volatile("ds_read_b128 %0, %1 offset:1024" : "=v"(fb[1]) : "v"(baddr));
    asm volatile("ds_read_b128 %0, %1 offset:2048" : "=v"(fb[2]) : "v"(baddr));
    asm volatile("ds_read_b128 %0, %1 offset:3072" : "=v"(fb[3]) : "v"(baddr));
    asm volatile("s_waitcnt lgkmcnt(0)" : "+v"(fa[0]), "+v"(fa[1]), "+v"(fa[2]), "+v"(fa[3]), "+v"(fa[4]), "+v"(fa[5]), "+v"(fa[6]), "+v"(fa[7]), "+v"(fb[0]), "+v"(fb[1]), "+v"(fb[2]), "+v"(fb[3]));
    const bool doiss = kt + 2 < nk;
    const int s2 = (sc == 0) ? 2 : sc - 1;
#pragma unroll
    for (int mi = 0; mi < 8; ++mi) {
#pragma unroll
      for (int ni = 0; ni < 4; ++ni) acc[mi][ni] = mfma16(fb[ni], fa[mi], acc[mi][ni]);
      if (mi < 6 && doiss) issue1(kt + 2, s2, mi);
      __builtin_amdgcn_sched_barrier(0);
    }
    sc = (sc == 2) ? 0 : sc + 1;
  }
  __syncthreads();
  if constexpr (!STAGED) {
#pragma unroll
    for (int mi = 0; mi < 8; ++mi)
#pragma unroll
      for (int ni = 0; ni < 4; ++ni) epi(m0 + wr * 128 + mi * 16 + fr, n0 + wc * 64 + ni * 16 + fq * 4, acc[mi][ni], mi, ni);
  } else {
    char* wb = lds + wid * 18432;
#pragma unroll
    for (int mi = 0; mi < 8; ++mi)
#pragma unroll
      for (int ni = 0; ni < 4; ++ni) {
        const f32x4 v = epi(m0 + wr * 128 + mi * 16 + fr, n0 + wc * 64 + ni * 16 + fq * 4, acc[mi][ni], mi, ni);
        uint2 w; w.x = pk2(v[0], v[1]); w.y = pk2(v[2], v[3]);
        *(uint2*)(wb + (mi * 16 + fr) * 144 + (ni * 16 + fq * 4) * 2) = w;
      }
    __builtin_amdgcn_wave_barrier();
    asm volatile("s_waitcnt lgkmcnt(0)" ::: "memory");
    const int rr = lane >> 3, ch = lane & 7;
    bf16_t* dp = dst + (size_t)(m0 + wr * 128 + rr) * ldd + n0 + wc * 64 + ch * 8;
#pragma unroll
    for (int it = 0; it < 16; ++it) {
      const u32x4 v = *(const u32x4*)(wb + (it * 8 + rr) * 144 + ch * 16);
      *(u32x4*)(dp + (size_t)it * 8 * ldd) = v;
    }
  }
}
DEV bool xcd_tile256(int L, int x, int NT, int GW, int& mt, int& nt) {
  if (L >= 8 * NT) return false;
  const int gs = 8 * GW; const int ng = L / gs, rem = L - ng * gs; const int ml = rem / GW;
  mt = ml * 8 + x; nt = ng * GW + (rem - ml * GW); return true;
}

DEV void st_bf16x4(bf16_t* p, f32x4 v) { uint2 w; w.x = pk2(v[0], v[1]); w.y = pk2(v[2], v[3]); *(uint2*)p = w; }
DEV f32x4 ld_bf16x4(const bf16_t* p) { uint2 w = *(const uint2*)p; return (f32x4){lo2f(w.x), hi2f(w.x), lo2f(w.y), hi2f(w.y)}; }

struct PrepJob { const float* src; bf16_t* dst; const float* gain; int K, Nsrc, Npad, perm; };

DEV PrepJob get_job(KP P, int jid) {
  bf16_t* W = (bf16_t*)(P->ws + OFF_W);
  PrepJob j; j.gain = nullptr; j.perm = 0;
  if (jid < 4) { j.src = P->ple_gate + (size_t)jid * 1048576; j.dst = W + WE_GATE + (size_t)jid * 1048576; j.K = 1024; j.Nsrc = 1024; j.Npad = 1024; return j; }
  jid -= 4;
  if (jid < 4) { j.src = P->ple_proj + (size_t)jid * 262144; j.dst = W + WE_PPROJ + (size_t)jid * 262144; j.K = 256; j.Nsrc = 1024; j.Npad = 1024; return j; }
  jid -= 4;
  const int l = jid & 1; const int t = jid >> 1;
  switch (t) {
    case 0: j.src = P->ev_w_in + (size_t)l * 1024 * 2560; j.dst = W + WE_EVIN + (size_t)l * 2560 * 1024; j.K = 1024; j.Nsrc = 2560; j.Npad = 2560; j.gain = P->pre_norm + (2 * l) * 1024; break;
    case 1: j.src = P->w_glu + (size_t)l * 262144; j.dst = W + WE_GLU + (size_t)l * 262144; j.K = 512; j.Nsrc = 512; j.Npad = 512; break;
    case 2: j.src = P->w_pw + (size_t)l * 262144; j.dst = W + WE_PW + (size_t)l * 262144; j.K = 512; j.Nsrc = 512; j.Npad = 512; break;
    case 3: j.src = P->ev_w_out + (size_t)l * 1048576; j.dst = W + WE_EVOUT + (size_t)l * 1048576; j.K = 1024; j.Nsrc = 1024; j.Npad = 1024; break;
    case 4: j.src = P->od_w_in + (size_t)l * 1024 * 2744; j.dst = W + WE_ODIN + (size_t)l * 2816 * 1024; j.K = 1024; j.Nsrc = 2744; j.Npad = 2816; j.gain = P->pre_norm + (2 * l + 1) * 1024; j.perm = 1; break;
    case 5: j.src = P->ck_w1 + (size_t)l * 524288; j.dst = W + WE_CK1 + (size_t)l * 524288; j.K = 2048; j.Nsrc = 256; j.Npad = 256; break;
    case 6: j.src = P->cv_w1 + (size_t)l * 524288; j.dst = W + WE_CV1 + (size_t)l * 524288; j.K = 2048; j.Nsrc = 256; j.Npad = 256; break;
    case 7: j.src = P->ck_w2 + (size_t)l * 16384; j.dst = W + WE_CK2 + (size_t)l * 32768; j.K = 256; j.Nsrc = 64; j.Npad = 64; break;
    case 8: j.src = P->cv_w2 + (size_t)l * 16384; j.dst = W + WE_CV2 + (size_t)l * 32768; j.K = 256; j.Nsrc = 64; j.Npad = 64; break;
    case 9: j.src = P->w_uq + (size_t)l * 196608; j.dst = W + WE_UQ + (size_t)l * 196608; j.K = 256; j.Nsrc = 768; j.Npad = 768; j.gain = P->q_norm + l * 256; j.perm = 2; break;
    case 10: j.src = P->w_ukv + (size_t)l * 131072; j.dst = W + WE_UKV + (size_t)l * 131072; j.K = 128; j.Nsrc = 1024; j.Npad = 1024; j.gain = P->kv_norm + l * 128; break;
    default: j.src = P->od_w_out + (size_t)l * 1048576; j.dst = W + WE_ODOUT + (size_t)l * 1048576; j.K = 1024; j.Nsrc = 1024; j.Npad = 1024; break;
  }
  return j;
}
constexpr int N_PREP_JOBS = 8 + 24;

DEV int perm_col(int perm, int n) {
  if (perm == 1) {
    if (n < 1280) return n;
    if (n < 2176) return n + 24;
    if (n < 2208) { int i = n - 2176; return 2200 + ((i & 1) * 16 + (i >> 1)); }
    if (n < 2720) return n + 24;
    if (n < 2744) return 1280 + (n - 2720);
    return -1;
  }
  if (perm == 2) {
    int h = n / 96, c = n - h * 96;
    if (c < 64) return n;
    int i = c - 64; return h * 96 + 64 + ((i & 1) * 16 + (i >> 1));
  }
  return n;
}

__device__ void prep_tile(const PrepJob& j, int tile, char* lds) {
  float* tl = (float*)lds;
  const int ntn = j.Npad >> 6;
  const int kt = tile / ntn, nt = tile - kt * ntn;
  const int k0 = kt * 64, n0 = nt * 64;
  int tid_ = threadIdx.x; asm volatile("" : "+v"(tid_));
  const int tid = tid_, tx = tid & 63, ty = tid >> 6;
  const int sc = perm_col(j.perm, n0 + tx);
  __syncthreads();
#pragma unroll
  for (int r = 0; r < 16; ++r) {
    const int k = k0 + ty * 16 + r;
    float v = 0.f;
    if (sc >= 0) { v = j.src[(size_t)k * j.Nsrc + sc]; if (j.gain) v *= j.gain[k]; }
    tl[(ty * 16 + r) * 65 + tx] = v;
  }
  __syncthreads();
  const int nl = tid >> 2, ks = (tid & 3) * 16;
  uint32_t w[8];
#pragma unroll
  for (int i = 0; i < 8; ++i) w[i] = pk2(tl[(ks + 2 * i) * 65 + nl], tl[(ks + 2 * i + 1) * 65 + nl]);
  bf16_t* d = j.dst + (size_t)(n0 + nl) * j.K + k0 + ks;
  *(uint4*)d = make_uint4(w[0], w[1], w[2], w[3]);
  *(uint4*)(d + 8) = make_uint4(w[4], w[5], w[6], w[7]);
}

__device__ void prep_tile4(const PrepJob& j, int tile, char* lds) {
  float* tl = (float*)lds;
  const int ntn = j.Npad >> 8;
  const int kt = tile / ntn, nq = tile - kt * ntn;
  const int k0 = kt * 64, n0 = nq * 256;
  int tid_ = threadIdx.x; asm volatile("" : "+v"(tid_));
  const int tid = tid_, tx = tid & 63, ty = tid >> 6;
  float v[4][16];
#pragma unroll
  for (int w = 0; w < 4; ++w) {
    const int sc = perm_col(j.perm, n0 + w * 64 + tx);
    const float* sp = j.src + (size_t)(k0 + ty * 16) * j.Nsrc + (sc >= 0 ? sc : 0);
#pragma unroll
    for (int r = 0; r < 16; ++r) { const float t = sp[(size_t)r * j.Nsrc]; v[w][r] = (sc >= 0) ? t : 0.f; }
  }
  float g[16];
#pragma unroll
  for (int r = 0; r < 16; ++r) g[r] = j.gain ? j.gain[k0 + ty * 16 + r] : 1.0f;
  __syncthreads();
#pragma unroll
  for (int w = 0; w < 4; ++w)
#pragma unroll
    for (int r = 0; r < 16; ++r) tl[w * 4160 + (ty * 16 + r) * 65 + tx] = v[w][r] * g[r];
  __syncthreads();
  const int nl = tid >> 2, ks = (tid & 3) * 16;
#pragma unroll
  for (int w = 0; w < 4; ++w) {
    uint32_t pw[8];
#pragma unroll
    for (int i = 0; i < 8; ++i) pw[i] = pk2(tl[w * 4160 + (ks + 2 * i) * 65 + nl], tl[w * 4160 + (ks + 2 * i + 1) * 65 + nl]);
    bf16_t* d = j.dst + (size_t)(n0 + w * 64 + nl) * j.K + k0 + ks;
    *(uint4*)d = make_uint4(pw[0], pw[1], pw[2], pw[3]);
    *(uint4*)(d + 8) = make_uint4(pw[4], pw[5], pw[6], pw[7]);
  }
}
__device__ void phase_prologue(KP P, char* lds) {
  const int tid = ltid(), lane = tid & 63, wid = tid >> 6;
  const int G = gridDim.x, bid = blockIdx.x;
  int base = 0;
  for (int jid = 0; jid < N_PREP_JOBS; ++jid) {
    PrepJob j = get_job(P, jid);
    const bool wide = (j.Npad & 255) == 0;
    const int nt = (j.K >> 6) * (wide ? (j.Npad >> 8) : (j.Npad >> 6));
    int start = (bid - (base % G) + G) % G;
    for (int t = start; t < nt; t += G) { if (wide) prep_tile4(j, t, lds); else prep_tile(j, t, lds); }
    base += nt;
  }
  {
    bf16_t* hb2 = (bf16_t*)(P->ws + OFF_HB2);
    float* rspre = (float*)(P->ws + OFF_MV);
    for (int row = bid * 4 + wid; row < T_TOK; row += G * 4) {
      const float* xr = P->x + (size_t)row * DM;
      float ss = 0.f;
#pragma unroll
      for (int i = 0; i < 4; ++i) {
        float4 v = *(const float4*)(xr + i * 256 + lane * 4);
        ss += v.x * v.x + v.y * v.y + v.z * v.z + v.w * v.w;
        uint2 w; w.x = pk2(v.x, v.y); w.y = pk2(v.z, v.w);
        *(uint2*)(hb2 + (size_t)row * DM + i * 256 + lane * 4) = w;
      }
#pragma unroll
      for (int o = 32; o > 0; o >>= 1) ss += __shfl_xor(ss, o);
      if (lane < 16) rspre[(size_t)row * 16 + lane] = (lane == 0) ? ss : 0.f;
    }
  }
  {
    float4* s5a = (float4*)(P->ws + OFF_S5A);
    for (int idx = bid * NTHREADS + tid; idx < 2 * 32 * 64; idx += G * NTHREADS) {
      const int j = idx >> 11, g = (idx >> 6) & 31;
      const float step = expf(P->log_step[j * 32 + g]);
      const float lr = P->lam_re[idx], li = P->lam_im[idx];
      const float zr = lr * step;
      const float th = li * step, the = fmaf(li, step, -th);
      const float em1 = zr * fmaf(zr, fmaf(zr, fmaf(zr, fmaf(zr, fmaf(zr, 1.98412698e-4f, 1.38888889e-3f), 8.33333333e-3f), 4.16666667e-2f), 1.66666667e-1f), 0.5f) * zr + zr;
      const float mag = 1.0f + em1;
      float sn, cs; fsincos_q(th, the, sn, cs);
      float sh, ch; fsincos_q(0.5f * th, 0.5f * the, sh, ch);
      const float ar = mag * cs, ai = mag * sn;
      const float magL = expf(64.0f * zr); float snL, csL; fsincos_q(64.0f * th, 64.0f * the, snL, csL);
      s5a[idx] = make_float4(ar, ai, magL * csL, magL * snL);
      const float den = lr * lr + li * li;
      const float nr = em1 * cs - 2.0f * sh * sh, ni = ai;
      const float fr = (nr * lr + ni * li) / den, fi = (ni * lr - nr * li) / den;
      bf16_t* bbT = (bf16_t*)(P->ws + OFF_BBR);
      const size_t rb = ((size_t)(idx >> 6) * 128 + (idx & 63)) * 16;
      for (int c = 0; c < 16; ++c) {
        const float br = P->b_re[(size_t)idx * 16 + c], bi = P->b_im[(size_t)idx * 16 + c];
        bbT[rb + c] = f2bf(fr * br - fi * bi);
        bbT[rb + 64 * 16 + c] = f2bf(fr * bi + fi * br);
      }
    }
    bf16_t* cm = (bf16_t*)(P->ws + OFF_CM);
    for (int idx = bid * NTHREADS + tid; idx < 2 * 32 * 16 * 128; idx += G * NTHREADS) {
      const int k = idx & 127, jgc = idx >> 7;
      float v = (k < 64) ? P->c_re[(size_t)jgc * 64 + k] : -P->c_im[(size_t)jgc * 64 + (k - 64)];
      cm[idx] = f2bf(v);
    }
  }
  {
    float2* tab = (float2*)(P->ws + OFF_ROPE);
    for (int idx = bid * NTHREADS + tid; idx < T_TOK * 16; idx += G * NTHREADS) {
      const int tok = idx >> 4, i = idx & 15;
      const float ang = (float)P->pos[tok] * rope_freq(i);
      float sn, cs; fsincos_q(ang, 0.f, sn, cs);
      tab[idx] = make_float2(cs, sn);
    }
  }
  {
    float* part = (float*)(P->ws + OFF_HID);
    for (int u = bid; u < 128; u += G) {
      const int jk = u >> 5, sl = u & 31; const int j = jk >> 1, kv = jk & 1;
      const float* pos = (kv ? P->pos_v : P->pos_k) + j * 2048 + sl * 64;
      const float* w1 = (kv ? P->cv_w1 : P->ck_w1) + (size_t)j * 524288 + (size_t)sl * 64 * 256 + tid;
      float s = 0.f;
#pragma unroll 16
      for (int k = 0; k < 64; ++k) s += pos[k] * w1[(size_t)k * 256];
      part[(size_t)u * 256 + tid] = s;
    }
  }
  {
    bf16_t* kc = (bf16_t*)(P->ws + OFF_KC); bf16_t* vc = (bf16_t*)(P->ws + OFF_VC);
    for (int idx = bid * NTHREADS + tid; idx < 8 * 128; idx += G * NTHREADS) {
      const int b = idx >> 7, e = idx & 127;
      kc[(size_t)(b * 128 + 127) * 128 + e] = 0; vc[(size_t)(b * 128 + 127) * 128 + e] = 0;
    }
  }
}

__device__ void convert_p(KP P, int layer) {
  const float* src = P->p + (size_t)layer * T_TOK * 256;
  bf16_t* pb = (bf16_t*)(P->ws + OFF_PB);
  const int tidc = ltid();
  for (size_t i = (size_t)blockIdx.x * NTHREADS + tidc; i < (size_t)T_TOK * 256 / 8; i += (size_t)gridDim.x * NTHREADS) {
    float4 a = *(const float4*)(src + i * 8), b = *(const float4*)(src + i * 8 + 4);
    *(uint4*)(pb + i * 8) = make_uint4(pk2(a.x, a.y), pk2(a.z, a.w), pk2(b.x, b.y), pk2(b.z, b.w));
  }
}

DEV bool xcd_tile(int L, int x, int NT, int GW, int& mt, int& nt) {
  if (L >= 16 * NT) return false;
  const int gs = 16 * GW; const int ng = L / gs, rem = L - ng * gs; const int ml = rem / GW;
  mt = ml * 8 + x; nt = ng * GW + (rem - ml * GW); return true;
}
__device__ void phase_win(KP P, int layer, char* lds) {
  const bool odd = layer & 1; const int j = layer >> 1;
  const bf16_t* W = (const bf16_t*)(P->ws + OFF_W);
  const bf16_t* Bt = odd ? W + WE_ODIN + (size_t)j * 2816 * 1024 : W + WE_EVIN + (size_t)j * 2560 * 1024;
  const int NT = odd ? 22 : 20;
  const bf16_t* hb2 = (const bf16_t*)(P->ws + OFF_HB2);
  bf16_t* proj = (bf16_t*)(P->ws + OFF_PROJ);
  const float* rspre = (const float*)(P->ws + OFF_MV);
  float* gl = (float*)(P->ws + OFF_GL);
  bf16_t* mk = (bf16_t*)(P->ws + OFF_MK);
  for (int L = blockIdx.x >> 3; ; L += gridDim.x >> 3) {
    int mt, nt; if (!xcd_tile256(L, blockIdx.x & 7, NT, NT >> 1, mt, nt)) break;
    auto arow = [&](int r) { return hb2 + (size_t)r * DM; };
    auto epi = [&](int m, int n, f32x4 v, int, int) {
      const float4* rp = (const float4*)(rspre + (size_t)m * 16);
      const float4 r0 = rp[0], r1 = rp[1], r2 = rp[2], r3 = rp[3];
      const float ssq_ = ((r0.x + r0.y) + (r0.z + r0.w)) + ((r1.x + r1.y) + (r1.z + r1.w)) + ((r2.x + r2.y) + (r2.z + r2.w)) + ((r3.x + r3.y) + (r3.z + r3.w));
      const float rstd = rsqrtf(ssq_ * (1.0f / 1024.0f) + 1e-6f);
      v = v * rstd;
      if (!odd) { st_bf16x4(proj + (size_t)m * LDP + n, v); return; }
      if (n < 512) { v = v * (0.125f * LOG2E); st_bf16x4(proj + (size_t)m * LDP + n, v); return; }
      if (n >= 2176 && n < 2208) {
        const int i0 = (n - 2176) >> 1;
        v = rope4(v, (const float2*)(P->ws + OFF_ROPE), m, i0);
        bf16_t* d = mk + (size_t)m * 768 + 64 + (n - 2176);
#pragma unroll
        for (int h = 0; h < 8; ++h) st_bf16x4(d + h * 96, v);
        return;
      }
      if (n >= 2720) { if (n < 2744) *(f32x4*)(gl + (size_t)m * 32 + (n - 2720)) = v; return; }
      st_bf16x4(proj + (size_t)m * LDP + n, v);
    };
    const bool plain = !odd || (nt != 17 && nt != 21);
    if (plain) {
      const float qs = (odd && nt < 4) ? (0.125f * LOG2E) : 1.0f;
      auto epis = [&](int m, int, f32x4 v, int, int) -> f32x4 {
        const float4* rp = (const float4*)(rspre + (size_t)m * 16);
        const float4 r0 = rp[0], r1 = rp[1], r2 = rp[2], r3 = rp[3];
        const float ssq_ = ((r0.x + r0.y) + (r0.z + r0.w)) + ((r1.x + r1.y) + (r1.z + r1.w)) + ((r2.x + r2.y) + (r2.z + r2.w)) + ((r3.x + r3.y) + (r3.z + r3.w));
        return v * (rsqrtf(ssq_ * (1.0f / 1024.0f) + 1e-6f) * qs);
      };
      gemm256<true>(arow, 64, Bt, 1024, mt * 256, nt * 128, 1024, lds, epis, proj, LDP);
    } else {
      gemm256<false>(arow, 64, Bt, 1024, mt * 256, nt * 128, 1024, lds, epi);
    }
  }
  convert_p(P, layer);
  if (layer == 0 && blockIdx.x < 4) {
    const int t_ = ltid(); const int jk = blockIdx.x;
    const float* part = (const float*)(P->ws + OFF_HID);
    float s = 0.f;
    for (int sl = 0; sl < 32; ++sl) s += part[(size_t)(jk * 32 + sl) * 256 + t_];
    ((float*)(P->ws + OFF_POSB))[jk * 256 + t_] = s;
  }
}

template <int PASS>
__device__ void s5_unit(KP P, int j, int unit, char* lds) {
  int tid_ = threadIdx.x; asm volatile("" : "+v"(tid_));
  const int tid = tid_, lane = tid & 63, wid = tid >> 6;
  const int fr = lane & 15, fq = lane >> 4;
  const int cq = unit & 7, g = (unit >> 3) & 31, b = unit >> 8;
  const int k = cq * 4 + wid; const int t0 = k * 64;
  const bf16_t* proj = (const bf16_t*)(P->ws + OFF_PROJ);
  float* st = (float*)(P->ws + OFF_MK) + ((size_t)(b * 32 + g) * 32) * 128;
  bf16_t* xs = (bf16_t*)(lds + wid * 8704);
  float* bu = (float*)(lds + 34816 + wid * 8448);
  const bf16x8 zero8 = (bf16x8){0, 0, 0, 0, 0, 0, 0, 0};
  bf16x8 uf[4], bbf[8];
  {
    const bf16_t* up = proj + (size_t)(b * SEQL + t0 + fr) * LDP + g * 16 + (fq & 1) * 8;
#pragma unroll
    for (int sb = 0; sb < 4; ++sb) { bf16x8 v = ld8(up + (size_t)sb * 16 * LDP); uf[sb] = (fq < 2) ? v : zero8; }
    const bf16_t* bp_ = (const bf16_t*)(P->ws + OFF_BBR) + ((size_t)(j * 32 + g) * 128 + fr) * 16 + (fq & 1) * 8;
#pragma unroll
    for (int ns = 0; ns < 8; ++ns) { bf16x8 v = ld8(bp_ + ns * 256); bbf[ns] = (fq < 2) ? v : zero8; }
  }
  const int pidx = (j * 32 + g) * 64 + lane;
  const float4 a4 = ((const float4*)(P->ws + OFF_S5A))[pidx];
  const float ar = a4.x, ai = a4.y;
  float xr = 0.f, xi = 0.f;
  if (PASS == 3) {
    const float aLr = a4.z, aLi = a4.w;
#pragma unroll 8
    for (int jj = 0; jj < 32; ++jj) {
      const float sr = st[jj * 128 + lane], si = st[jj * 128 + 64 + lane];
      const float nr = aLr * xr - aLi * xi + sr, ni = aLr * xi + aLi * xr + si;
      xr = (jj < k) ? nr : xr; xi = (jj < k) ? ni : xi;
    }
  }
  bf16x8 cf[4]; float4 dsk = make_float4(0.f, 0.f, 0.f, 0.f);
  if (PASS == 3) {
    const bf16_t* cm = (const bf16_t*)(P->ws + OFF_CM) + ((size_t)(j * 32 + g) * 16 + fr) * 128 + fq * 8;
#pragma unroll
    for (int kk = 0; kk < 4; ++kk) cf[kk] = ld8(cm + kk * 32);
    dsk = *(const float4*)(P->s5_d + j * 512 + g * 16 + fq * 4);
  }
  bf16_t* ya = (bf16_t*)(P->ws + OFF_HB2);
#pragma unroll 1
  for (int sb = 0; sb < 4; ++sb) {
    __syncthreads();
#pragma unroll
    for (int ns = 0; ns < 8; ++ns) {
      bf16x8 ufs = uf[0];
      ufs = (sb == 1) ? uf[1] : ufs; ufs = (sb == 2) ? uf[2] : ufs; ufs = (sb == 3) ? uf[3] : ufs;
      const f32x4 acc = mfma16(bbf[ns], ufs, (f32x4){0.f, 0.f, 0.f, 0.f});
      *(f32x4*)(bu + fr * 132 + ns * 16 + fq * 4) = acc;
    }
    __syncthreads();
#pragma unroll
    for (int t = 0; t < 16; ++t) {
      const float bur = bu[t * 132 + lane], bui = bu[t * 132 + 64 + lane];
      const float nr = ar * xr - ai * xi + bur, ni = ar * xi + ai * xr + bui;
      xr = nr; xi = ni;
      if (PASS == 3) { const int row = (sb & 1) * 16 + t; xs[row * 136 + lane] = f2bf(xr); xs[row * 136 + 64 + lane] = f2bf(xi); }
    }
    if (PASS == 3 && (sb & 1)) {
      __syncthreads();
      const int half = sb >> 1;
#pragma unroll
      for (int tt = 0; tt < 2; ++tt) {
        f32x4 acc = (f32x4){0.f, 0.f, 0.f, 0.f};
#pragma unroll
        for (int kk = 0; kk < 4; ++kk) {
          bf16x8 xf = *(const bf16x8*)(xs + (tt * 16 + fr) * 136 + kk * 32 + fq * 8);
          acc = mfma16(cf[kk], xf, acc);
        }
        const int tl = half * 32 + tt * 16 + fr;
        const f32x4 uu = ld_bf16x4(proj + (size_t)(b * SEQL + t0 + tl) * LDP + g * 16 + fq * 4);
        f32x4 y;
        y[0] = gelu_tanh(acc[0] + dsk.x * uu[0]); y[1] = gelu_tanh(acc[1] + dsk.y * uu[1]);
        y[2] = gelu_tanh(acc[2] + dsk.z * uu[2]); y[3] = gelu_tanh(acc[3] + dsk.w * uu[3]);
        st_bf16x4(ya + (size_t)(b * SEQL + t0 + tl) * 512 + g * 16 + fq * 4, y);
      }
    }
  }
  if (PASS == 1) { st[k * 128 + lane] = xr; st[k * 128 + 64 + lane] = xi; }
}

__device__ void conv_unit(KP P, int j, int unit, char* lds) {
  int tid_ = threadIdx.x; asm volatile("" : "+v"(tid_));
  const int tid = tid_, lane = tid & 63, wid = tid >> 6;
  const int b = unit >> 7, tt = unit & 127; const int t0 = tt * 16;
  const bf16_t* proj = (const bf16_t*)(P->ws + OFF_PROJ);
  bf16_t* hs = (bf16_t*)lds;
  float* red = (float*)(lds + 47104);
  __syncthreads();
#pragma unroll
  for (int bt = 0; bt < 3; ++bt) {
    u32x4 av[4], gv[4];
#pragma unroll
    for (int i = 0; i < 4; ++i) {
      const int id = tid + (bt * 4 + i) * NTHREADS;
      const int r = id >> 6, c8 = (id & 63) * 8;
      const int t = t0 - 30 + r;
      av[i] = (u32x4){0u, 0u, 0u, 0u}; gv[i] = (u32x4){0u, 0u, 0u, 0u};
      if (id < 46 * 64 && t >= 0) {
        const bf16_t* pa = proj + (size_t)(b * SEQL + t) * LDP + 1024 + c8;
        av[i] = *(const u32x4*)pa; gv[i] = *(const u32x4*)(pa + 512);
      }
    }
#pragma unroll
    for (int i = 0; i < 4; ++i) {
      const int id = tid + (bt * 4 + i) * NTHREADS;
      const int r = id >> 6, c8 = (id & 63) * 8;
      u32x4 o;
#pragma unroll
      for (int q = 0; q < 4; ++q) o[q] = pk2(lo2f(av[i][q]) * sigmoidf_(lo2f(gv[i][q])), hi2f(av[i][q]) * sigmoidf_(hi2f(gv[i][q])));
      if (id < 46 * 64) *(u32x4*)(hs + r * 512 + c8) = o;
    }
  }
  const int c0 = tid * 2;
  float w0[31], w1[31];
  const float* wp = P->w_dw + (size_t)j * 31 * 512 + c0;
#pragma unroll
  for (int kk = 0; kk < 31; ++kk) { float2 w = *(const float2*)(wp + kk * 512); w0[kk] = w.x; w1[kk] = w.y; }
  float a0[16], a1[16];
#pragma unroll
  for (int t = 0; t < 16; ++t) { a0[t] = 0.f; a1[t] = 0.f; }
  __syncthreads();
#pragma unroll
  for (int r = 0; r < 46; ++r) {
    const uint32_t hv = *(const uint32_t*)(hs + r * 512 + c0);
    const float h0 = lo2f(hv), h1 = hi2f(hv);
#pragma unroll
    for (int t = 0; t < 16; ++t) {
      const int kk = r - t;
      if (kk >= 0 && kk <= 30) { a0[t] += w0[kk] * h0; a1[t] += w1[kk] * h1; }
    }
  }
  const float2 bd = *(const float2*)(P->b_dw + j * 512 + c0);
  const float2 lg = *(const float2*)(P->ln_g + j * 512 + c0);
  const float2 lb = *(const float2*)(P->ln_b + j * 512 + c0);
  float mu[16];
#pragma unroll
  for (int t = 0; t < 16; ++t) {
    a0[t] += bd.x; a1[t] += bd.y;
    float s = a0[t] + a1[t];
#pragma unroll
    for (int o = 32; o > 0; o >>= 1) s += __shfl_xor(s, o);
    mu[t] = s;
  }
  __syncthreads();
  if (lane == 0) {
#pragma unroll
    for (int t = 0; t < 16; ++t) red[wid * 16 + t] = mu[t];
  }
  __syncthreads();
#pragma unroll
  for (int t = 0; t < 16; ++t) mu[t] = (red[t] + red[16 + t] + red[32 + t] + red[48 + t]) * (1.0f / 512.0f);
  float vr[16];
#pragma unroll
  for (int t = 0; t < 16; ++t) {
    const float d0 = a0[t] - mu[t], d1 = a1[t] - mu[t];
    float s = d0 * d0 + d1 * d1;
#pragma unroll
    for (int o = 32; o > 0; o >>= 1) s += __shfl_xor(s, o);
    vr[t] = s;
  }
  __syncthreads();
  if (lane == 0) {
#pragma unroll
    for (int t = 0; t < 16; ++t) red[wid * 16 + t] = vr[t];
  }
  __syncthreads();
  bf16_t* hc = (bf16_t*)(P->ws + OFF_HB2) + (size_t)T_TOK * 512;
#pragma unroll
  for (int t = 0; t < 16; ++t) {
    const float var = (red[t] + red[16 + t] + red[32 + t] + red[48 + t]) * (1.0f / 512.0f);
    const float rstd = rsqrtf(var + 1e-6f);
    const float y0 = siluf_((a0[t] - mu[t]) * rstd * lg.x + lb.x), y1 = siluf_((a1[t] - mu[t]) * rstd * lg.y + lb.y);
    *(uint32_t*)(hc + (size_t)(b * SEQL + t0 + t) * 512 + c0) = pk2(y0, y1);
  }
}

DEV int remap_bx(int v, int per_b) {
  if (gridDim.x != 512) return v;
  const int r = v >> 9, bid = v & 511; return (bid & 7) * per_b + (bid >> 3) + 64 * r;
}
DEV int remap_nsa(int u) {
  if (gridDim.x != 512) return u;
  const int r = u >> 9, bid = u & 511, x = bid & 7, sl = bid >> 3;
  const int grp = x + 8 * r, b = grp >> 1, hkv = grp & 1, tt = r == 0 ? 63 - sl : sl;
  return b * 128 + hkv * 64 + (b < 4 ? 63 - tt : tt);
}
DEV int remap_mla(int u) {
  if (gridDim.x != 512) return u;
  const int r = u >> 9, bid = u & 511, x = bid & 7, sl = bid >> 3;
  const int grp = x + 8 * (sl & 7), q = sl >> 3, qt = r == 0 ? 15 - q : q;
  return qt >= 8 ? (15 - qt) * 64 + grp : 512 + qt * 64 + grp;
}
__device__ void phase_even_a(KP P, int layer, char* lds) {
  const int j = layer >> 1;
  for (int u = blockIdx.x; u < 2048 + 1024; u += gridDim.x) {
    if (u < 1024) conv_unit(P, j, remap_bx(u, 128), lds); else s5_unit<1>(P, j, remap_bx(u - 1024, 256), lds);
  }
}
__device__ void phase_even_b(KP P, int layer, char* lds) {
  const int j = layer >> 1;
  const bf16_t* W = (const bf16_t*)(P->ws + OFF_W);
  const bf16_t* hc = (const bf16_t*)(P->ws + OFF_HB2) + (size_t)T_TOK * 512;
  const bf16_t* proj = (const bf16_t*)(P->ws + OFF_PROJ);
  bf16_t* mix = (bf16_t*)(P->ws + OFF_MIX);
  for (int u = blockIdx.x; u < 2048 + 512; u += gridDim.x) {
    if (u < 2048) { s5_unit<3>(P, j, remap_bx(u, 256), lds); continue; }
    const int tile = u - 2048; const int mt = tile >> 2, nt = tile & 3;
    auto arow = [&](int r) { return hc + (size_t)r * 512; };
    auto epi = [&](int m, int n, f32x4 v, int, int) -> f32x4 {
      f32x4 gb = ld_bf16x4(proj + (size_t)m * LDP + 2048 + n);
      f32x4 o;
#pragma unroll
      for (int i = 0; i < 4; ++i) o[i] = v[i] * siluf_(gb[i]);
      return o;
    };
    gemm128<true>(arow, 64, W + WE_PW + (size_t)j * 262144, 512, mt * 128, nt * 128, 512, lds, epi, mix + 512 + nt * 128, DM, mix + 512 + nt * 128 + 64, DM);
  }
}
__device__ void phase_even_c(KP P, int layer, char* lds) {
  const int j = layer >> 1;
  const bf16_t* W = (const bf16_t*)(P->ws + OFF_W);
  const bf16_t* ya = (const bf16_t*)(P->ws + OFF_HB2);
  const bf16_t* proj = (const bf16_t*)(P->ws + OFF_PROJ);
  bf16_t* mix = (bf16_t*)(P->ws + OFF_MIX);
  for (int L = blockIdx.x >> 3; ; L += gridDim.x >> 3) {
    int mt, nt; if (!xcd_tile(L, blockIdx.x & 7, 4, 4, mt, nt)) break;
    auto arow = [&](int r) { return ya + (size_t)r * 512; };
    auto epi = [&](int m, int n, f32x4 v, int, int) -> f32x4 {
      const float4 bg = *(const float4*)(P->b_glu + j * 512 + n);
      f32x4 yv = ld_bf16x4(ya + (size_t)m * 512 + n);
      f32x4 ga = ld_bf16x4(proj + (size_t)m * LDP + 512 + n);
      f32x4 o;
      o[0] = yv[0] * sigmoidf_(v[0] + bg.x) * siluf_(ga[0]); o[1] = yv[1] * sigmoidf_(v[1] + bg.y) * siluf_(ga[1]);
      o[2] = yv[2] * sigmoidf_(v[2] + bg.z) * siluf_(ga[2]); o[3] = yv[3] * sigmoidf_(v[3] + bg.w) * siluf_(ga[3]);
      return o;
    };
    gemm128<true>(arow, 64, W + WE_GLU + (size_t)j * 262144, 512, mt * 128, nt * 128, 512, lds, epi, mix + nt * 128, DM, mix + nt * 128 + 64, DM);
  }
}

__device__ void phase_out(KP P, int layer, char* lds) {
  const int j = layer >> 1;
  const bf16_t* W = (const bf16_t*)(P->ws + OFF_W);
  const bf16_t* Bt = (layer & 1) ? W + WE_ODOUT + (size_t)j * 1048576 : W + WE_EVOUT + (size_t)j * 1048576;
  const bf16_t* mix = (const bf16_t*)(P->ws + OFF_MIX);
  float* y = (float*)(P->ws + OFF_PROJ);
  float* rspost = (float*)(P->ws + OFF_HB2);
  for (int L = blockIdx.x >> 3; ; L += gridDim.x >> 3) {
    int mt, nt; if (!xcd_tile256(L, blockIdx.x & 7, 8, 8, mt, nt)) break;
    float ssq[8] = {0.f, 0.f, 0.f, 0.f, 0.f, 0.f, 0.f, 0.f};
    auto arow = [&](int r) { return mix + (size_t)r * DM; };
    auto epi = [&](int m, int n, f32x4 v, int mi, int) {
      *(f32x4*)(y + (size_t)m * DM + n) = v;
      ssq[mi] += v[0] * v[0] + v[1] * v[1] + v[2] * v[2] + v[3] * v[3];
    };
    gemm256<false>(arow, 64, Bt, 1024, mt * 256, nt * 128, 1024, lds, epi);
    const int tl_ = ltid(); const int lane = tl_ & 63, wid = tl_ >> 6;
#pragma unroll
    for (int mi = 0; mi < 8; ++mi) {
      float s = ssq[mi]; s += __shfl_xor(s, 16); s += __shfl_xor(s, 32);
      if (lane < 16) rspost[(size_t)(mt * 256 + (wid >> 1) * 128 + mi * 16 + lane) * 16 + nt * 2 + (wid & 1)] = s;
    }
  }
}
__device__ void phase_rowpass(KP P, int layer) {
  const int tl_ = ltid(); const int lane = tl_ & 63, wid = tl_ >> 6;
  const float* y = (const float*)(P->ws + OFF_PROJ);
  const float* rspost = (const float*)(P->ws + OFF_HB2);
  const float* hsrc = layer == 0 ? P->x : P->out;
  bf16_t* hb1 = (bf16_t*)(P->ws + OFF_MIX);
  const float* pg = P->post_norm + layer * DM;
  for (int row = blockIdx.x * 4 + wid; row < T_TOK; row += gridDim.x * 4) {
    float sq = (lane < 16) ? rspost[(size_t)row * 16 + lane] : 0.f;
#pragma unroll
    for (int o = 8; o > 0; o >>= 1) sq += __shfl_xor(sq, o);
    sq = __shfl(sq, 0);
    const float rstd = rsqrtf(sq * (1.0f / 1024.0f) + 1e-6f);
#pragma unroll
    for (int i = 0; i < 4; ++i) {
      const int c = i * 256 + lane * 4;
      float4 yv = *(const float4*)(y + (size_t)row * DM + c);
      float4 hv = *(const float4*)(hsrc + (size_t)row * DM + c);
      float4 g = *(const float4*)(pg + c);
      hv.x += yv.x * rstd * g.x; hv.y += yv.y * rstd * g.y; hv.z += yv.z * rstd * g.z; hv.w += yv.w * rstd * g.w;
      uint2 w; w.x = pk2(hv.x, hv.y); w.y = pk2(hv.z, hv.w);
      *(uint2*)(hb1 + (size_t)row * DM + c) = w;
    }
  }
}
__device__ void phase_ple(KP P, int layer, char* lds) {
  const bf16_t* W = (const bf16_t*)(P->ws + OFF_W);
  const bf16_t* gate_t = W + WE_GATE + (size_t)layer * 1048576;
  const bf16_t* pproj_t = W + WE_PPROJ + (size_t)layer * 262144;
  const bf16_t* hb1 = (const bf16_t*)(P->ws + OFF_MIX);
  const bf16_t* pb = (const bf16_t*)(P->ws + OFF_PB);
  bf16_t* hb2 = (bf16_t*)(P->ws + OFF_HB2);
  float* rspre = (float*)(P->ws + OFF_MV);
  for (int L = blockIdx.x >> 3; ; L += gridDim.x >> 3) {
    int mt, nt; if (!xcd_tile(L, blockIdx.x & 7, 8, 8, mt, nt)) break;
    uint32_t stash[4][4][2];
    auto arow2 = [&](int r) { return pb + (size_t)r * 256; };
    auto epi2 = [&](int, int, f32x4 v, int mi, int ni) { stash[mi][ni][0] = pk2(v[0], v[1]); stash[mi][ni][1] = pk2(v[2], v[3]); };
    gemm128(arow2, 64, pproj_t, 256, mt * 128, nt * 128, 256, lds, epi2);
    float ssq[4] = {0.f, 0.f, 0.f, 0.f};
    auto arow = [&](int r) { return hb1 + (size_t)r * DM; };
    auto epi = [&](int m, int n, f32x4 v, int mi, int ni) -> f32x4 {
      const f32x4 t4 = ld_bf16x4(hb1 + (size_t)m * DM + n);
      float4 hv = make_float4(t4[0], t4[1], t4[2], t4[3]);
      const uint32_t s0 = stash[mi][ni][0], s1 = stash[mi][ni][1];
      hv.x += sigmoidf_(v[0]) * lo2f(s0); hv.y += sigmoidf_(v[1]) * hi2f(s0);
      hv.z += sigmoidf_(v[2]) * lo2f(s1); hv.w += sigmoidf_(v[3]) * hi2f(s1);
      *(float4*)(P->out + (size_t)m * DM + n) = hv;
      ssq[mi] += hv.x * hv.x + hv.y * hv.y + hv.z * hv.z + hv.w * hv.w;
      return (f32x4){hv.x, hv.y, hv.z, hv.w};
    };
    gemm128<true>(arow, 64, gate_t, 1024, mt * 128, nt * 128, 1024, lds, epi, hb2 + nt * 128, DM, hb2 + nt * 128 + 64, DM);
    const int tl_ = ltid(); const int lane = tl_ & 63, wid = tl_ >> 6;
#pragma unroll
    for (int mi = 0; mi < 4; ++mi) {
      float s = ssq[mi]; s += __shfl_xor(s, 16); s += __shfl_xor(s, 32);
      if (lane < 16) rspre[(size_t)(mt * 128 + (wid >> 1) * 64 + mi * 16 + lane) * 16 + nt * 2 + (wid & 1)] = s;
    }
  }
}

__device__ void phase_odd_a(KP P, int layer, char* lds) {
  const int j = layer >> 1;
  const bf16_t* W = (const bf16_t*)(P->ws + OFF_W);
  const bf16_t* proj = (const bf16_t*)(P->ws + OFF_PROJ);
  bf16_t* hid = (bf16_t*)(P->ws + OFF_HID);
  const float* posb = (const float*)(P->ws + OFF_POSB);
  bf16_t* mq = (bf16_t*)(P->ws + OFF_HB2); bf16_t* mk = (bf16_t*)(P->ws + OFF_MK); bf16_t* mv = (bf16_t*)(P->ws + OFF_MV);
  float* rs = (float*)(lds + 65536);
  const int tid = ltid();
  const int G_ = gridDim.x; const bool split_ = G_ > 128;
  for (int u = split_ ? (blockIdx.x < 64 ? (int)blockIdx.x : 64 + ((int)blockIdx.x - 64)) : (int)blockIdx.x; u < 64 + 768 + 1024;
       u += split_ ? (blockIdx.x < 64 ? (1 << 30) : (G_ - 64)) : G_) {
    if (u < 64) {
      const int kv = u >> 5, mt = (u >> 1) & 15, nt = u & 1;
      const bf16_t* Bt = (kv ? W + WE_CV1 : W + WE_CK1) + (size_t)j * 524288;
      auto arow = [&](int r) { int R = r < 2032 ? r : 2031; int b = R / 254, rem = R - b * 254; int c = rem >> 1, hk = rem & 1;
        return proj + (size_t)(b * SEQL + 16 * c) * LDP + 512 + kv * 128 + hk * 64; };
      auto epi = [&](int m, int n, f32x4 v, int, int) {
        if (m >= 2032) return;
        const float4 pbv = *(const float4*)(posb + (j * 2 + kv) * 256 + n);
        f32x4 o; o[0] = gelu_tanh(v[0] + pbv.x); o[1] = gelu_tanh(v[1] + pbv.y); o[2] = gelu_tanh(v[2] + pbv.z); o[3] = gelu_tanh(v[3] + pbv.w);
        st_bf16x4(hid + ((size_t)kv * 2048 + m) * 256 + n, o);
      };
      gemm128(arow, LDP, Bt, 2048, mt * 128, nt * 128, 2048, lds, epi);
      continue;
    }
    const bool isq = u < 64 + 768;
    int mt, nt;
    if (isq) { int t = u - 64; mt = t / 6; nt = t - mt * 6; } else { int t = u - 64 - 768; mt = t >> 3; nt = t & 7; }
    const int KK = isq ? 256 : 128; const int coff = isq ? 1792 : 2048;
    __syncthreads();
    {
      const int r = tid >> 1, hf = tid & 1; const int len = KK >> 1;
      const bf16_t* src = proj + (size_t)(mt * 128 + r) * LDP + coff + hf * len;
      float ss = 0.f;
      for (int i = 0; i < len; i += 8) { uint4 a = *(const uint4*)(src + i);
        float f0 = lo2f(a.x), f1 = hi2f(a.x), f2 = lo2f(a.y), f3 = hi2f(a.y), f4 = lo2f(a.z), f5 = hi2f(a.z), f6 = lo2f(a.w), f7 = hi2f(a.w);
        ss += f0 * f0 + f1 * f1 + f2 * f2 + f3 * f3 + f4 * f4 + f5 * f5 + f6 * f6 + f7 * f7; }
      ss += __shfl_xor(ss, 1);
      if (hf == 0) rs[r] = rsqrtf(ss / (float)KK + 1e-6f);
    }
    __syncthreads();
    auto arow = [&](int r) { return proj + (size_t)r * LDP + coff; };
    if (isq) {
      auto epi = [&](int m, int n, f32x4 v, int, int) -> f32x4 {
        v = v * rs[m - mt * 128];
        const int h = n / 96, c = n - h * 96;
        if (c >= 64) { const int i0 = (c - 64) >> 1; v = rope4(v, (const float2*)(P->ws + OFF_ROPE), m, i0); }
        return v * (0.10206207261596575f * LOG2E);
      };
      gemm128<true>(arow, 64, W + WE_UQ + (size_t)j * 196608, 256, mt * 128, nt * 128, 256, lds, epi, mq + nt * 128, 768, mq + nt * 128 + 64, 768);
    } else {
      auto epi = [&](int m, int, f32x4 v, int, int) -> f32x4 { return v * rs[m - mt * 128]; };
      gemm128<true>(arow, 64, W + WE_UKV + (size_t)j * 131072, 128, mt * 128, nt * 128, 128, lds, epi, mk + nt * 96, 768, mv + nt * 64, 512);
    }
  }
}
__device__ void phase_odd_b(KP P, int layer, char* lds) {
  const int j = layer >> 1;
  const bf16_t* W = (const bf16_t*)(P->ws + OFF_W);
  const bf16_t* hid = (const bf16_t*)(P->ws + OFF_HID);
  for (int u = blockIdx.x; u < 32; u += gridDim.x) {
    const int kv = u >> 4, mt = u & 15;
    bf16_t* dst = (bf16_t*)(P->ws + (kv ? OFF_VC : OFF_KC));
    const bf16_t* Bt = (kv ? W + WE_CV2 : W + WE_CK2) + (size_t)j * 32768;
    auto arow = [&](int r) { return hid + ((size_t)kv * 2048 + r) * 256; };
    auto epi = [&](int m, int n, f32x4 v, int, int) {
      if (m >= 2032 || n >= 64) return;
      const int b = m / 254, rem = m - b * 254; const int c = rem >> 1, hk = rem & 1;
      st_bf16x4(dst + ((size_t)(b * 128 + c) * 2 + hk) * 64 + n, v);
    };
    gemm128(arow, 64, Bt, 256, mt * 128, 0, 256, lds, epi);
  }
}

constexpr int LDS_KR = 16384, LDS_V = 20480, LDS_PSLC = 40960, LDS_SELM = 45056, LDS_OC = 46080;
DEV int swz_rope(int row, int c) { return row * 64 + ((c ^ ((0x1320 >> (((row >> 2) & 3) * 4)) & 3)) << 4); }

template <int DQK>
struct KVRegs { u32x4 k[DQK == 96 ? 3 : 2]; u32x4 v[2]; };

template <int DQK>
DEV void kv_load(KVRegs<DQK>& R, const bf16_t* Kb, size_t ldk, const bf16_t* Vb, size_t ldv, int key0, int tid) {
  constexpr int CPR = DQK / 8;
#pragma unroll
  for (int i = 0; i < (DQK == 96 ? 3 : 2); ++i) { const int id = tid + i * 256; const int row = id / CPR, c = id - row * CPR; R.k[i] = *(const u32x4*)(Kb + (size_t)(key0 + row) * ldk + c * 8); }
#pragma unroll
  for (int i = 0; i < 2; ++i) { const int id = tid + i * 256; const int row = id >> 3, c = id & 7; R.v[i] = *(const u32x4*)(Vb + (size_t)(key0 + row) * ldv + c * 8); }
}
template <int DQK>
DEV void kv_store(const KVRegs<DQK>& R, char* lds, int rowoff, int tid) {
  constexpr int CPR = DQK / 8;
#pragma unroll
  for (int i = 0; i < (DQK == 96 ? 3 : 2); ++i) { const int id = tid + i * 256; const int row = id / CPR, c = id - row * CPR;
    if (c < 8) *(u32x4*)(lds + swz(rowoff + row, c)) = R.k[i]; else *(u32x4*)(lds + LDS_KR + swz_rope(row, c - 8)) = R.k[i]; }
#pragma unroll
  for (int i = 0; i < 2; ++i) { const int id = tid + i * 256; const int row = id >> 3, c = id & 7; *(u32x4*)(lds + LDS_V + (rowoff + row) * 160 + c * 16) = R.v[i]; }
}
DEV bf16x8 v_frag(const char* lds, int rowbase, int dd, int lane) {
  const int g = lane >> 4, q = (lane >> 2) & 3, p = lane & 3;
  const char* a = lds + LDS_V + (rowbase + 4 * g + q) * 160 + (dd * 16 + 4 * p) * 2;
  s16x4 lo = __builtin_amdgcn_ds_read_tr16_b64_v4i16((__attribute__((address_space(3))) s16x4*)(a));
  s16x4 hi = __builtin_amdgcn_ds_read_tr16_b64_v4i16((__attribute__((address_space(3))) s16x4*)(a + 16 * 160));
  return (bf16x8){lo[0], lo[1], lo[2], lo[3], hi[0], hi[1], hi[2], hi[3]};
}
DEV bf16x8 pack_p(f32x4 a, f32x4 b) { union { uint4 u; bf16x8 v; } c; c.u = make_uint4(pk2(a[0], a[1]), pk2(a[2], a[3]), pk2(b[0], b[1]), pk2(b[2], b[3])); return c.v; }

template <int DQK, int MODE>
DEV void flash_loop(const bf16x8 (&qf)[2][DQK / 32], int qpos0, int wq_min, int wq_max,
                    const bf16_t* Kb, size_t ldk, const bf16_t* Vb, size_t ldv,
                    int kt0, int kt1, uint32_t tilemask, float slope2, uint32_t sm0, uint32_t sm1,
                    char* lds, f32x4 (&O)[2][4], float (&m)[2], float (&l)[2], int tid) {
  const int lane = tid & 63; const int fr = lane & 15, fq = lane >> 4;
  KVRegs<DQK> R;
  int kt = kt0;
  if (MODE == 2) { kt = tilemask ? __builtin_ctz(tilemask) : kt1; }
  if (kt < kt1) kv_load<DQK>(R, Kb, ldk, Vb, ldv, kt * 64, tid);
  while (kt < kt1) {
    __syncthreads();
    kv_store<DQK>(R, lds, 0, tid);
    __syncthreads();
    int nxt = kt + 1;
    if (MODE == 2) { uint32_t rem = tilemask & ~((2u << kt) - 1u); nxt = rem ? __builtin_ctz(rem) : kt1; }
    if (nxt < kt1) kv_load<DQK>(R, Kb, ldk, Vb, ldv, nxt * 64, tid);
    bool skip = (kt * 64 > wq_max);
    if (MODE == 1) skip = skip || (wq_min - (kt * 64 + 63) >= 512);
    if (!skip) {
      const bool full = (MODE == 0) ? (kt * 64 + 63 <= wq_min)
                      : (MODE == 1) ? ((kt * 64 + 63 <= wq_min) && (wq_max - kt * 64 < 512)) : false;
      bf16x8 pf[2][2];
#pragma unroll
      for (int qi = 0; qi < 2; ++qi) {
        f32x4 s[4];
#pragma unroll
        for (int ks = 0; ks < 4; ++ks) {
          s[ks] = (f32x4){0.f, 0.f, 0.f, 0.f};
#pragma unroll
          for (int kk = 0; kk < 2; ++kk) s[ks] = mfma16(*(const bf16x8*)(lds + swz(ks * 16 + fr, kk * 4 + fq)), qf[qi][kk], s[ks]);
          if (DQK == 96) s[ks] = mfma16(*(const bf16x8*)(lds + LDS_KR + swz_rope(ks * 16 + fr, fq)), qf[qi][DQK / 32 - 1], s[ks]);
        }
        const int qp = qpos0 + qi * 16;
        const uint32_t smq = qi ? sm1 : sm0;
        const int qoff = qp - (kt * 64 + fq * 4);
        const float bias0 = -slope2 * (float)qoff;
        float mx = -1e30f;
        if (full) {
#pragma unroll
          for (int ks = 0; ks < 4; ++ks)
#pragma unroll
            for (int jj = 0; jj < 4; ++jj) {
              float sc = s[ks][jj];
              if (MODE != 0) sc = sc + (bias0 + slope2 * (float)(ks * 16 + jj));
              s[ks][jj] = sc; mx = fmaxf(mx, sc);
            }
        } else {
          const bool selok = (MODE == 2) ? (((smq >> kt) & 1u) != 0u) : true;
#pragma unroll
          for (int ks = 0; ks < 4; ++ks)
#pragma unroll
            for (int jj = 0; jj < 4; ++jj) {
              const int dist = qoff - (ks * 16 + jj);
              bool valid = (dist >= 0) && selok;
              if (MODE == 1) valid = valid && (dist < 512);
              float sc = s[ks][jj];
              if (MODE != 0) sc = sc + (bias0 + slope2 * (float)(ks * 16 + jj));
              sc = valid ? sc : -INFINITY;
              s[ks][jj] = sc; mx = fmaxf(mx, sc);
            }
        }
        mx = fmaxf(mx, __shfl_xor(mx, 16)); mx = fmaxf(mx, __shfl_xor(mx, 32));
        const float mnew = fmaxf(m[qi], mx);
        const float alpha = fexp2(m[qi] - mnew);
        m[qi] = mnew;
        float ps = 0.f;
#pragma unroll
        for (int ks = 0; ks < 4; ++ks)
#pragma unroll
          for (int jj = 0; jj < 4; ++jj) { const float pv = fexp2(s[ks][jj] - mnew); s[ks][jj] = pv; ps += pv; }
        l[qi] = l[qi] * alpha + ps;
#pragma unroll
        for (int dd = 0; dd < 4; ++dd) O[qi][dd] = O[qi][dd] * alpha;
        pf[qi][0] = pack_p(s[0], s[1]); pf[qi][1] = pack_p(s[2], s[3]);
      }
#pragma unroll
      for (int dd = 0; dd < 4; ++dd)
#pragma unroll
        for (int s2 = 0; s2 < 2; ++s2) {
          const bf16x8 vf = v_frag(lds, s2 * 32, dd, lane);
          O[0][dd] = mfma16(vf, pf[0][s2], O[0][dd]);
          O[1][dd] = mfma16(vf, pf[1][s2], O[1][dd]);
        }
    }
    kt = nxt;
  }
}

__device__ void nsa_unit(KP P, int unit, char* lds) {
  int tid_ = threadIdx.x; asm volatile("" : "+v"(tid_));
  const int tid = tid_, lane = tid & 63, wid = tid >> 6;
  const int fr = lane & 15, fq = lane >> 4;
  const int tt = (unit < 512) ? 63 - (unit & 63) : (unit & 63); const int hkv = (unit >> 6) & 1, b = unit >> 7;
  const int t0 = tt * 32; const int hd = hkv * 4 + wid;
  const bf16_t* proj = (const bf16_t*)(P->ws + OFF_PROJ);
  const bf16_t* prb = proj + (size_t)b * SEQL * LDP;
  const float* gl = (const float*)(P->ws + OFF_GL) + (size_t)b * SEQL * 32;
  const float slope2 = exp2f(-(float)(hd + 1)) * LOG2E;
  float* pslc = (float*)(lds + LDS_PSLC);
  uint32_t* selm = (uint32_t*)(lds + LDS_SELM);
  bf16x8 qf[2][2];
#pragma unroll
  for (int qi = 0; qi < 2; ++qi)
#pragma unroll
    for (int kk = 0; kk < 2; ++kk) qf[qi][kk] = ld8(prb + (size_t)(t0 + qi * 16 + fr) * LDP + hd * 64 + kk * 32 + fq * 8);
  const int qpos0 = t0 + fr;
  f32x4* ocl = (f32x4*)(lds + LDS_OC) + tid;
  float contrib[2][8];
  __syncthreads();
  {
    const bf16_t* kc = (const bf16_t*)(P->ws + OFF_KC) + (size_t)b * 128 * 128 + hkv * 64;
    const bf16_t* vc = (const bf16_t*)(P->ws + OFF_VC) + (size_t)b * 128 * 128 + hkv * 64;
#pragma unroll
    for (int i = 0; i < 4; ++i) { const int id = tid + i * 256; const int row = id >> 3, c = id & 7;
      *(uint4*)(lds + swz(row, c)) = *(const uint4*)(kc + (size_t)row * 128 + c * 8);
      *(uint4*)(lds + LDS_V + row * 160 + c * 16) = *(const uint4*)(vc + (size_t)row * 128 + c * 8); }
  }
  __syncthreads();
#pragma unroll
  for (int qi = 0; qi < 2; ++qi) {
    f32x4 oc[2][4];
    f32x4 s[8];
#pragma unroll
    for (int ks = 0; ks < 8; ++ks) {
      s[ks] = (f32x4){0.f, 0.f, 0.f, 0.f};
#pragma unroll
      for (int kk = 0; kk < 2; ++kk) s[ks] = mfma16(*(const bf16x8*)(lds + swz(ks * 16 + fr, kk * 4 + fq)), qf[qi][kk], s[ks]);
    }
    const int qp = qpos0 + qi * 16;
    float mx = -1e30f;
#pragma unroll
    for (int ks = 0; ks < 8; ++ks)
#pragma unroll
      for (int jj = 0; jj < 4; ++jj) {
        const int c = ks * 16 + fq * 4 + jj; const int dist = qp - (16 * c + 31);
        const bool valid = (dist >= 0) && (c < 127);
        float sc = s[ks][jj] - slope2 * (float)dist; sc = valid ? sc : -1e30f; s[ks][jj] = sc; mx = fmaxf(mx, sc);
      }
    mx = fmaxf(mx, __shfl_xor(mx, 16)); mx = fmaxf(mx, __shfl_xor(mx, 32));
    float ps = 0.f;
#pragma unroll
    for (int ks = 0; ks < 8; ++ks)
#pragma unroll
      for (int jj = 0; jj < 4; ++jj) { const float sv = s[ks][jj]; const float pv = (sv > -1e29f) ? fexp2(sv - mx) : 0.f; s[ks][jj] = pv; ps += pv; }
    ps += __shfl_xor(ps, 16); ps += __shfl_xor(ps, 32);
    const float inv = 1.0f / fmaxf(ps, 1e-30f);
    {
      float xprev = 0.f;
#pragma unroll
      for (int ks = 0; ks < 8; ++ks) {
        s[ks] = s[ks] * inv;
        const float x1 = __shfl(s[ks][3], (lane + 48) & 63);
        contrib[qi][ks] = ((s[ks][0] + s[ks][1]) + (s[ks][2] + s[ks][3])) + (fq > 0 ? x1 : xprev);
        xprev = x1;
      }
    }
#pragma unroll
    for (int dd = 0; dd < 4; ++dd) oc[qi][dd] = (f32x4){0.f, 0.f, 0.f, 0.f};
#pragma unroll
    for (int s2 = 0; s2 < 4; ++s2) {
      const bf16x8 pfr = pack_p(s[2 * s2], s[2 * s2 + 1]);
#pragma unroll
      for (int dd = 0; dd < 4; ++dd) oc[qi][dd] = mfma16(v_frag(lds, s2 * 32, dd, lane), pfr, oc[qi][dd]);
    }
    const float g0 = sigmoidf_(gl[(size_t)(t0 + qi * 16 + fr) * 32 + hd]);
#pragma unroll
    for (int dd = 0; dd < 4; ++dd) ocl[(qi * 4 + dd) * 256] = oc[qi][dd] * g0;
  }
#pragma unroll
  for (int w = 0; w < 4; ++w) {
    if (wid == w) {
#pragma unroll
      for (int qi = 0; qi < 2; ++qi)
#pragma unroll
        for (int ks = 0; ks < 8; ++ks) {
          float* pp = pslc + (qi * 16 + fr) * 32 + ks * 4 + fq;
          if (w == 0) *pp = contrib[qi][ks]; else *pp += contrib[qi][ks];
        }
    }
    __syncthreads();
  }
  const int cur = t0 >> 6;
  {
    uint32_t mask = 0;
    if (tid < 32) {
      if (cur + 1 <= 8) mask = (2u << cur) - 1u;
      else {
        mask = 1u | (1u << cur) | (1u << (cur - 1));
        const float* pr = pslc + tid * 32;
        for (int r = 0; r < 5; ++r) {
          int best = 1; float bv = -1.0f;
          for (int jb = 1; jb <= cur - 2; ++jb) { const float v = pr[jb]; if (!((mask >> jb) & 1u) && v > bv) { bv = v; best = jb; } }
          mask |= 1u << best;
        }
      }
      selm[tid] = mask;
    }
    if (wid == 0) {
      uint32_t um = mask;
#pragma unroll
      for (int o = 32; o > 0; o >>= 1) um |= __shfl_xor(um, o);
      if (lane == 0) selm[32] = um;
    }
  }
  __syncthreads();
  const uint32_t sm0 = selm[fr], sm1 = selm[16 + fr], umask = selm[32];
  {
    f32x4 O[2][4]; float m[2] = {-1e30f, -1e30f}, l[2] = {0.f, 0.f};
#pragma unroll
    for (int qi = 0; qi < 2; ++qi)
#pragma unroll
      for (int dd = 0; dd < 4; ++dd) O[qi][dd] = (f32x4){0.f, 0.f, 0.f, 0.f};
    flash_loop<64, 2>(qf, qpos0, t0, t0 + 31, prb + 512 + 2 * 128 + hkv * 64, LDP, prb + 512 + 3 * 128 + hkv * 64, LDP,
                      0, cur + 1, umask, slope2, sm0, sm1, lds, O, m, l, tid);
#pragma unroll
    for (int qi = 0; qi < 2; ++qi) {
      float ls = l[qi]; ls += __shfl_xor(ls, 16); ls += __shfl_xor(ls, 32);
      const float g1 = sigmoidf_(gl[(size_t)(t0 + qi * 16 + fr) * 32 + 8 + hd]) / fmaxf(ls, 1e-30f);
#pragma unroll
      for (int dd = 0; dd < 4; ++dd) ocl[(qi * 4 + dd) * 256] += O[qi][dd] * g1;
    }
  }
  bf16_t* mixp = (bf16_t*)(P->ws + OFF_MIX) + (size_t)b * SEQL * DM;
  {
    f32x4 O[2][4]; float m[2] = {-1e30f, -1e30f}, l[2] = {0.f, 0.f};
#pragma unroll
    for (int qi = 0; qi < 2; ++qi)
#pragma unroll
      for (int dd = 0; dd < 4; ++dd) O[qi][dd] = (f32x4){0.f, 0.f, 0.f, 0.f};
    int k0 = (t0 - 511) >> 6; if (k0 < 0) k0 = 0;
    flash_loop<64, 1>(qf, qpos0, t0, t0 + 31, prb + 512 + 4 * 128 + hkv * 64, LDP, prb + 512 + 5 * 128 + hkv * 64, LDP,
                      k0, cur + 1, 0u, slope2, 0u, 0u, lds, O, m, l, tid);
#pragma unroll
    for (int qi = 0; qi < 2; ++qi) {
      float ls = l[qi]; ls += __shfl_xor(ls, 16); ls += __shfl_xor(ls, 32);
      const float g2 = sigmoidf_(gl[(size_t)(t0 + qi * 16 + fr) * 32 + 16 + hd]) / fmaxf(ls, 1e-30f);
      const int tok = t0 + qi * 16 + fr;
#pragma unroll
      for (int dd = 0; dd < 4; ++dd) {
        const int d = hd * 64 + dd * 16 + fq * 4;
        f32x4 gn = ld_bf16x4(prb + (size_t)tok * LDP + 1280 + d);
        f32x4 o = ocl[(qi * 4 + dd) * 256] + O[qi][dd] * g2;
#pragma unroll
        for (int i = 0; i < 4; ++i) o[i] *= siluf_(gn[i]);
        st_bf16x4(mixp + (size_t)tok * DM + d, o);
      }
    }
  }
}

__device__ void mla_unit(KP P, int unit, char* lds) {
  int tid_ = threadIdx.x; asm volatile("" : "+v"(tid_));
  const int tid = tid_, lane = tid & 63, wid = tid >> 6;
  const int fr = lane & 15, fq = lane >> 4;
  int qt; if (unit < 512) qt = 15 - (unit >> 6); else qt = (unit - 512) >> 6;
  const int bh = unit & 63; const int b = bh >> 3, hd = bh & 7;
  const int t0 = qt * 128 + wid * 32;
  const bf16_t* mq = (const bf16_t*)(P->ws + OFF_HB2) + (size_t)b * SEQL * 768 + hd * 96;
  const bf16_t* mk = (const bf16_t*)(P->ws + OFF_MK) + (size_t)b * SEQL * 768 + hd * 96;
  const bf16_t* mv = (const bf16_t*)(P->ws + OFF_MV) + (size_t)b * SEQL * 512 + hd * 64;
  bf16x8 qf[2][3];
#pragma unroll
  for (int qi = 0; qi < 2; ++qi)
#pragma unroll
    for (int kk = 0; kk < 3; ++kk) qf[qi][kk] = ld8(mq + (size_t)(t0 + qi * 16 + fr) * 768 + kk * 32 + fq * 8);
  f32x4 O[2][4]; float m[2] = {-1e30f, -1e30f}, l[2] = {0.f, 0.f};
#pragma unroll
  for (int qi = 0; qi < 2; ++qi)
#pragma unroll
    for (int dd = 0; dd < 4; ++dd) O[qi][dd] = (f32x4){0.f, 0.f, 0.f, 0.f};
  flash_loop<96, 0>(qf, t0 + fr, t0, t0 + 31, mk, 768, mv, 512, 0, qt * 2 + 2, 0u, 0.f, 0u, 0u, lds, O, m, l, tid);
  const bf16_t* prb = (const bf16_t*)(P->ws + OFF_PROJ) + (size_t)b * SEQL * LDP;
  bf16_t* mix = (bf16_t*)(P->ws + OFF_MIX) + (size_t)b * SEQL * DM;
#pragma unroll
  for (int qi = 0; qi < 2; ++qi) {
    float ls = l[qi]; ls += __shfl_xor(ls, 16); ls += __shfl_xor(ls, 32);
    const float inv = 1.0f / fmaxf(ls, 1e-30f);
#pragma unroll
    for (int dd = 0; dd < 4; ++dd) {
      const int tok = t0 + qi * 16 + fr; const int d = hd * 64 + dd * 16 + fq * 4;
      f32x4 gm = ld_bf16x4(prb + (size_t)tok * LDP + 2208 + d);
      f32x4 o = O[qi][dd] * inv;
#pragma unroll
      for (int i = 0; i < 4; ++i) o[i] *= siluf_(gm[i]);
      st_bf16x4(mix + (size_t)tok * DM + 512 + d, o);
    }
  }
}
__device__ void phase_odd_c(KP P, int layer, char* lds) {
  for (int u = blockIdx.x; u < 1024 + 1024; u += gridDim.x) {
#ifndef ATT_ONLY
#define ATT_ONLY 3
#endif
    if (u < 1024) { if (ATT_ONLY & 1) nsa_unit(P, remap_nsa(u), lds); } else { if (ATT_ONLY & 2) mla_unit(P, remap_mla(u - 1024), lds); }
  }
}

#ifndef DBG_LAST
#define DBG_LAST -1
#endif
#ifndef DBG_WHICH
#define DBG_WHICH 0
#endif
__device__ void dbg_dump(KP P) {
  const int tid = ltid();
  const bf16_t* ya = (const bf16_t*)(P->ws + OFF_HB2);
  const bf16_t* hc = ya + (size_t)T_TOK * 512;
  const bf16_t* mix = (const bf16_t*)(P->ws + OFF_MIX);
  const bf16_t* proj = (const bf16_t*)(P->ws + OFF_PROJ);
  const float* y = (const float*)(P->ws + OFF_PROJ);
  for (size_t i = (size_t)blockIdx.x * NTHREADS + tid; i < (size_t)T_TOK * DM; i += (size_t)gridDim.x * NTHREADS) {
    const size_t m = i >> 10; const int n = (int)(i & 1023);
    float v;
    if (DBG_WHICH == 0) v = bf2f(proj[m * LDP + n]);
    else if (DBG_WHICH == 1) v = bf2f(proj[m * LDP + 1024 + n]);
    else if (DBG_WHICH == 2) v = n < 512 ? bf2f(hc[m * 512 + n]) : ((const float*)(P->ws + OFF_MK))[(m * 512 + (n - 512)) & 1048575];
    else if (DBG_WHICH == 3) v = n < 512 ? bf2f(ya[m * 512 + n]) : bf2f(mix[m * DM + n]);
    else if (DBG_WHICH == 4) v = bf2f(mix[m * DM + n]);
    else if (DBG_WHICH == 5) v = y[m * DM + n];
    else if (DBG_WHICH == 7) v = bf2f(ya[m * DM + n]);
    else if (DBG_WHICH == 8) {
      const bf16_t* W = (const bf16_t*)(P->ws + OFF_W); const bf16_t* pb = (const bf16_t*)(P->ws + OFF_PB);
      if (n < 256) v = bf2f(pb[m * 256 + n]);
      else if (n < 512) v = bf2f(W[WE_PPROJ + ((m * 256 + (n - 256)) & 262143)]);
      else v = bf2f(W[WE_GATE + ((m * 512 + (n - 512)) & 1048575)]);
    }
    else v = bf2f(proj[m * LDP + 1536 + n]);
    P->out[i] = v;
  }
}
#define XB_TMO      128
#define XB_XCNT(j)  (256  + 64 * (j))
#define XB_XSUB(j)  (1280 + 64 * (j))
#define XB_XGEN(j)  (2304 + 64 * (j))
#define XB_TOP      3328
#define XB_TOPGEN   3392
#define XCD_BAR_WORDS 3456
#define XB_SPIN_CAP (1u << 20)
DEV unsigned xb_ld(unsigned* p)              { return __hip_atomic_load(p, __ATOMIC_RELAXED, __HIP_MEMORY_SCOPE_AGENT); }
DEV unsigned xb_add(unsigned* p, unsigned v) { return __hip_atomic_fetch_add(p, v, __ATOMIC_RELAXED, __HIP_MEMORY_SCOPE_AGENT); }
DEV unsigned xb_xcc_id() { return (unsigned)__builtin_amdgcn_s_getreg((3 << 11) | 20) & 0xFu; }
#define XB_SPIN(cond, bar) do { unsigned _sp = 0; while (cond) { __builtin_amdgcn_s_sleep(1); \
    if ((++_sp & 255u) == 0u) { if (xb_ld(&(bar)[XB_TMO])) break; if (_sp > XB_SPIN_CAP) { atomicAdd(&(bar)[XB_TMO], 1u); break; } } } } while (0)
struct XcdBarrier { unsigned* bar; unsigned x; volatile LAS3 unsigned* st; unsigned k; };
DEV XcdBarrier xcd_barrier_post(unsigned* bar, volatile LAS3 unsigned* st) {
  XcdBarrier b; b.bar = bar; b.x = xb_xcc_id(); b.st = st; b.k = 0u;
  if (threadIdx.x == 0) (void)xb_add(&bar[XB_XCNT(b.x)], 1u);
  return b;
}
DEV void xcd_barrier_complete(unsigned* bar, unsigned x, unsigned& nloc, unsigned& nx) {
  const unsigned G = gridDim.x;
  unsigned sum, cnt, mine, sp = 0u;
  for (;;) {
    sum = 0u; cnt = 0u; mine = 0u;
#pragma unroll
    for (unsigned j = 0; j < 16; ++j) { const unsigned c = xb_ld(&bar[XB_XCNT(j)]); sum += c; cnt += (c > 0u) ? 1u : 0u; mine = (j == x) ? c : mine; }
    if (sum == G) break;
    __builtin_amdgcn_s_sleep(1);
    if ((++sp & 255u) == 0u) { if (xb_ld(&bar[XB_TMO])) break; if (sp > XB_SPIN_CAP) { atomicAdd(&bar[XB_TMO], 1u); break; } }
  }
  nloc = mine > 0u ? mine : 1u; nx = cnt > 0u ? cnt : 1u;
}
DEV void xcd_barrier(XcdBarrier& b) {
  asm volatile("s_waitcnt vmcnt(0)" ::: "memory");
  __syncthreads();
  if (threadIdx.x == 0) {
    unsigned* bar = b.bar;
    __builtin_amdgcn_s_waitcnt(0);
    unsigned nloc = b.st[0], nx = b.st[1];
    if (nloc == 0u) { xcd_barrier_complete(bar, b.x, nloc, nx); b.st[0] = nloc; b.st[1] = nx; }
    const unsigned old = xb_add(&bar[XB_XSUB(b.x)], 1u);
    const unsigned gen = old / nloc;
    if (old + 1u == (gen + 1u) * nloc) {
      __builtin_amdgcn_fence(__ATOMIC_RELEASE, "agent");
      asm volatile("s_waitcnt vmcnt(0)" ::: "memory");
      const unsigned og = xb_add(&bar[XB_TOP], 1u);
      const unsigned tg = og / nx;
      if (og + 1u == (tg + 1u) * nx) xb_add(&bar[XB_TOPGEN], 1u);
      else XB_SPIN(xb_ld(&bar[XB_TOPGEN]) == tg, bar);
      __builtin_amdgcn_fence(__ATOMIC_ACQUIRE, "agent");
      asm volatile("s_waitcnt vmcnt(0)" ::: "memory");
    } else {
      (void)gen;
      XB_SPIN(xb_ld(&bar[XB_TOPGEN]) == b.k, bar);
      __builtin_amdgcn_fence(__ATOMIC_ACQUIRE, "agent");
      asm volatile("s_waitcnt vmcnt(0)" ::: "memory");
    }
  }
  b.k += 1u;
  __syncthreads();
}
#ifndef NLAY
#define NLAY 4
#endif
constexpr int N_PHASES = 1 + NLAY * 7;

__global__ void __launch_bounds__(NTHREADS, 2) fwd_kernel(Params Pin) {
  __shared__ __attribute__((aligned(16))) char lds_[LDS_BYTES];
  KP P0 = (KP)__builtin_amdgcn_kernarg_segment_ptr();
  const int ph_lo = P0->phase_lo, ph_hi = P0->phase_hi, coop = P0->coop;
  __shared__ uint4 xb_words;
  if (threadIdx.x == 0) xb_words = make_uint4(0u, 0u, 0u, 0u);
  __syncthreads();
  XcdBarrier xb = xcd_barrier_post((unsigned*)(P0->ws + OFF_BAR), (volatile LAS3 unsigned*)&xb_words);
  for (int ph = ph_lo; ph <= ph_hi; ++ph) {
    KP P = P0; asm volatile("" : "+s"(P));
    int lds_off = 0; asm volatile("" : "+s"(lds_off));
    char* lds = lds_ + lds_off;
#ifndef PHM
#define PHM 0xffff
#endif
#ifndef REP_PRO
#define REP_PRO 1
#endif
#ifndef REP_PLE
#define REP_PLE 1
#endif
    if (ph == 0) {
#pragma unroll 1
      for (int r_ = 0; r_ < REP_PRO; ++r_) phase_prologue(P, lds); }
    else {
      const int layer = (ph - 1) / 7, sub = (ph - 1) % 7;
      const bool odd = layer & 1;
      switch (sub) {
#ifndef REP_WIN
#define REP_WIN 1
#endif
#ifndef REP_OUT
#define REP_OUT 1
#endif
        case 0: if (PHM & 2) {
#pragma unroll 1
          for (int r_ = 0; r_ < REP_WIN; ++r_) phase_win(P, layer, lds); } break;
#ifndef REP_OA
#define REP_OA 1
#endif
#ifndef REP_OC
#define REP_OC 1
#endif
#ifndef REP_EA
#define REP_EA 1
#endif
#ifndef REP_EB
#define REP_EB 1
#endif
#ifndef REP_EC
#define REP_EC 1
#endif
#ifndef REP_RP
#define REP_RP 1
#endif
        case 1: if (odd) {
#pragma unroll 1
            for (int r_ = 0; r_ < REP_OA; ++r_) phase_odd_a(P, layer, lds);
          } else {
#pragma unroll 1
            for (int r_ = 0; r_ < REP_EA; ++r_) phase_even_a(P, layer, lds);
          } break;
        case 2: if (odd) { phase_odd_b(P, layer, lds); } else {
#pragma unroll 1
            for (int r_ = 0; r_ < REP_EB; ++r_) phase_even_b(P, layer, lds);
          } break;
        case 3: if (odd) {
#pragma unroll 1
            for (int r_ = 0; r_ < REP_OC; ++r_) phase_odd_c(P, layer, lds);
          } else {
#pragma unroll 1
            for (int r_ = 0; r_ < REP_EC; ++r_) phase_even_c(P, layer, lds);
          } break;
        case 4: if (PHM & 256) {
#pragma unroll 1
          for (int r_ = 0; r_ < REP_OUT; ++r_) phase_out(P, layer, lds); } break;
        case 5: {
#pragma unroll 1
          for (int r_ = 0; r_ < ((layer == 0) ? REP_RP : 1); ++r_) phase_rowpass(P, layer); } break;
        default: {
#pragma unroll 1
          for (int r_ = 0; r_ < REP_PLE; ++r_) phase_ple(P, layer, lds); } break;
      }
    }
#ifndef REP_SYNC
#define REP_SYNC 1
#endif
    if (ph < ph_hi && coop) {
      if (P0->pad0 != 0) cg::this_grid().sync();
      xcd_barrier(xb);
    }
  }
  if (DBG_LAST >= 0) { cg::this_grid().sync(); dbg_dump(P0); }
}

#ifndef USE_COOP
#define USE_COOP 1
#endif

extern "C" void kernel_launch(void* const* d_in, const int* in_sizes, int n_in, void* d_out, int out_size, void* d_ws, size_t ws_size, hipStream_t stream) {
  (void)in_sizes; (void)n_in; (void)out_size;
  if (ws_size < WS_NEED) { fprintf(stderr, "workspace too small: %zu < %zu\n", ws_size, (size_t)WS_NEED); return; }
  Params P{};
  int a = 0;
  P.x = (const float*)d_in[a++]; P.p = (const float*)d_in[a++]; P.pos = (const int*)d_in[a++];
  P.pre_norm = (const float*)d_in[a++]; P.post_norm = (const float*)d_in[a++]; P.ple_gate = (const float*)d_in[a++]; P.ple_proj = (const float*)d_in[a++];
  P.ev_w_in = (const float*)d_in[a++]; P.lam_re = (const float*)d_in[a++]; P.lam_im = (const float*)d_in[a++]; P.b_re = (const float*)d_in[a++]; P.b_im = (const float*)d_in[a++];
  P.c_re = (const float*)d_in[a++]; P.c_im = (const float*)d_in[a++]; P.s5_d = (const float*)d_in[a++]; P.log_step = (const float*)d_in[a++]; P.w_glu = (const float*)d_in[a++]; P.b_glu = (const float*)d_in[a++];
  P.w_dw = (const float*)d_in[a++]; P.b_dw = (const float*)d_in[a++]; P.ln_g = (const float*)d_in[a++]; P.ln_b = (const float*)d_in[a++]; P.w_pw = (const float*)d_in[a++]; P.ev_w_out = (const float*)d_in[a++];
  P.od_w_in = (const float*)d_in[a++]; P.pos_k = (const float*)d_in[a++]; P.pos_v = (const float*)d_in[a++]; P.ck_w1 = (const float*)d_in[a++]; P.ck_w2 = (const float*)d_in[a++]; P.cv_w1 = (const float*)d_in[a++]; P.cv_w2 = (const float*)d_in[a++];
  P.q_norm = (const float*)d_in[a++]; P.kv_norm = (const float*)d_in[a++]; P.w_uq = (const float*)d_in[a++]; P.w_ukv = (const float*)d_in[a++]; P.od_w_out = (const float*)d_in[a++];
  P.out = (float*)d_out; P.ws = (char*)d_ws;
  static int grid_blocks = 0;
  if (!grid_blocks) {
    int dev = 0, cus = 0, per_cu = 0;
    (void)hipGetDevice(&dev);
    (void)hipDeviceGetAttribute(&cus, hipDeviceAttributeMultiprocessorCount, dev);
    (void)hipOccupancyMaxActiveBlocksPerMultiprocessor(&per_cu, fwd_kernel, NTHREADS, 0);
    if (per_cu > 2) per_cu = 2;
    if (per_cu < 1) per_cu = 1;
    grid_blocks = cus * per_cu;
  }
#if USE_COOP
  (void)hipMemsetAsync((char*)d_ws + OFF_BAR, 0, 16384, stream);
  P.phase_lo = 0; P.phase_hi = (DBG_LAST >= 0) ? DBG_LAST : N_PHASES - 1; P.coop = 1;
  void* args[] = {&P};
  hipError_t e = hipLaunchCooperativeKernel((void*)fwd_kernel, dim3(grid_blocks), dim3(NTHREADS), args, 0, stream);
  if (e != hipSuccess) fprintf(stderr, "cooperative launch failed: %s (grid %d)\n", hipGetErrorString(e), grid_blocks);
#else
  for (int ph = 0; ph < N_PHASES; ++ph) {
    P.phase_lo = ph; P.phase_hi = ph; P.coop = 0;
    fwd_kernel<<<grid_blocks, NTHREADS, 0, stream>>>(P);
  }
#endif
}
```
